# Optimizing an MI355X kernel written in HIP

```python
import jax, jax.numpy as jnp
from jax import lax
import numpy as np

D_MODEL = 4096
BATCH = 2
SEQ = 4096
DEPTH = 4

D_MIX = D_MODEL
W_LRU = D_MIX // 2
W_ATT = D_MIX - W_LRU
LRU_BLOCKS = 16
LRU_BW = W_LRU // LRU_BLOCKS
CONV_W = 4
C_RG = 8.0
N_HEADS = 16
HEAD_DIM = W_ATT // N_HEADS
GRID_W = 64
WIN_R = 8
WIN_C = 16
EPS = 1e-6
D_IN = 2 * W_LRU + 4 * W_ATT

kernel_name = "hybrid_rglru_natten_parallel_heads"


def rms_norm(x, g):
    x32 = x.astype(jnp.float32)
    y = x32 * lax.rsqrt(jnp.mean(x32 * x32, axis=-1, keepdims=True) + EPS)
    return (y * g.astype(jnp.float32)).astype(x.dtype)


def _lin_combine(left, right):
    a_l, b_l = left
    a_r, b_r = right
    return a_l * a_r, a_r * b_l + b_r


def rglru_bidir(xa, conv_w, conv_b, wa, ba, wx, bx, lam):
    B, S, W = xa.shape
    xp = jnp.pad(xa, ((0, 0), (CONV_W // 2, CONV_W - 1 - CONV_W // 2), (0, 0)))
    xc = sum(xp[:, j:j + S] * conv_w[j] for j in range(CONV_W)) + conv_b
    xb = xc.reshape(B, S, LRU_BLOCKS, LRU_BW)
    r = jax.nn.sigmoid((jnp.einsum('bsnk,enkj->ebsnj', xb, wa).reshape(2, B, S, W)
                        + ba[:, None, None]).astype(jnp.float32))
    i = jax.nn.sigmoid((jnp.einsum('bsnk,enkj->ebsnj', xb, wx).reshape(2, B, S, W)
                        + bx[:, None, None]).astype(jnp.float32))
    log_a = -C_RG * r * jax.nn.softplus(-lam.astype(jnp.float32))[:, None, None]
    a = jnp.exp(log_a)
    b = jnp.sqrt(-jnp.expm1(2.0 * log_a)) * (i * xc.astype(jnp.float32)[None])
    _, h_f = lax.associative_scan(_lin_combine, (a[0], b[0]), axis=1)
    _, h_b = lax.associative_scan(_lin_combine, (a[1], b[1]), axis=1, reverse=True)
    return (h_f + h_b).astype(xa.dtype)


def neighbourhood_attention(q, k, v, rpb):
    B, S, H, Dh = q.shape
    rows = S // GRID_W
    kr = min(WIN_R, rows)
    kc = WIN_C
    scale = Dh ** -0.5
    qg = q.reshape(B, rows, GRID_W, H, Dh)
    kg = k.reshape(B, rows, GRID_W, H, Dh)
    vg = v.reshape(B, rows, GRID_W, H, Dh)
    col = jnp.arange(GRID_W)
    c_start = jnp.clip(col - kc // 2, 0, GRID_W - kc)
    col_idx = c_start[:, None] + jnp.arange(kc)
    col_off = col_idx - col[:, None] + (WIN_C - 1)

    def row_block(args):
        r, q_row = args
        r_start = jnp.clip(r - kr // 2, 0, rows - kr)
        row_idx = r_start + jnp.arange(kr)
        ridx = row_idx[:, None, None]
        cidx = col_idx[None]
        kb = kg[:, ridx, cidx]
        vb = vg[:, ridx, cidx]
        row_off = row_idx - r + (WIN_R - 1)
        bias = rpb[:, row_off[:, None, None], col_off[None]]
        bias = jnp.transpose(bias, (0, 2, 1, 3)).astype(jnp.float32)
        s = jnp.einsum('bchd,bkcwhd->bhckw', q_row, kb).astype(jnp.float32) * scale + bias
        p = jax.nn.softmax(s.reshape(B, H, GRID_W, kr * kc), axis=-1)
        p = p.reshape(B, H, GRID_W, kr, kc).astype(v.dtype)
        return jnp.einsum('bhckw,bkcwhd->bchd', p, vb)

    out = lax.map(row_block, (jnp.arange(rows), jnp.moveaxis(qg, 1, 0)))
    return jnp.moveaxis(out, 0, 1).reshape(B, S, H * Dh)


def hybrid_layer(x, cond, norm_g, w_ada, b_ada, w_in, conv_w, conv_b, lru_wa, lru_ba,
                 lru_wx, lru_bx, lru_lambda, rpb, gn_lru, gn_att, w_out):
    B, S, D = x.shape
    mod = cond @ w_ada + b_ada
    shift, scl, gate = jnp.split(mod, 3, axis=-1)
    h = rms_norm(x, norm_g) * (1.0 + scl[:, None]) + shift[:, None]
    p = h @ w_in
    cuts = [W_LRU, 2 * W_LRU, 2 * W_LRU + W_ATT, 2 * W_LRU + 2 * W_ATT, 2 * W_LRU + 3 * W_ATT]
    xa, ga, q, k, v, gb = jnp.split(p, cuts, axis=-1)
    ya = rglru_bidir(xa, conv_w, conv_b, lru_wa, lru_ba, lru_wx, lru_bx, lru_lambda)
    ya = rms_norm(ya, gn_lru) * jax.nn.silu(ga)
    yb = neighbourhood_attention(q.reshape(B, S, N_HEADS, HEAD_DIM),
                                 k.reshape(B, S, N_HEADS, HEAD_DIM),
                                 v.reshape(B, S, N_HEADS, HEAD_DIM), rpb)
    yb = rms_norm(yb, gn_att) * jax.nn.silu(gb)
    y = jnp.concatenate([ya, yb], axis=-1) @ w_out
    return x + gate[:, None] * y


def setup_inputs(seed: int = 0) -> dict:
    key = jax.random.key(seed)
    ks = jax.random.split(key, 20)
    nrm = jax.random.normal
    f32 = jnp.float32
    u = jax.random.uniform(ks[12], (DEPTH, 2, W_LRU), f32, 0.9, 0.999)
    a0 = u ** (1.0 / C_RG)
    return {
        "x": nrm(ks[0], (BATCH, SEQ, D_MODEL), f32),
        "c": nrm(ks[1], (BATCH, D_MODEL), f32),
        "norm_g": 1.0 + 0.01 * nrm(ks[2], (DEPTH, D_MODEL), f32),
        "w_ada": nrm(ks[3], (DEPTH, D_MODEL, 3 * D_MODEL), f32) * (0.5 * D_MODEL ** -0.5),
        "b_ada": 0.01 * nrm(ks[4], (DEPTH, 3 * D_MODEL), f32),
        "w_in": nrm(ks[5], (DEPTH, D_MODEL, D_IN), f32) * D_MODEL ** -0.5,
        "conv_w": nrm(ks[6], (DEPTH, CONV_W, W_LRU), f32) * CONV_W ** -0.5,
        "conv_b": 0.01 * nrm(ks[7], (DEPTH, W_LRU), f32),
        "lru_wa": nrm(ks[8], (DEPTH, 2, LRU_BLOCKS, LRU_BW, LRU_BW), f32) * LRU_BW ** -0.5,
        "lru_ba": 0.01 * nrm(ks[9], (DEPTH, 2, W_LRU), f32),
        "lru_wx": nrm(ks[10], (DEPTH, 2, LRU_BLOCKS, LRU_BW, LRU_BW), f32) * LRU_BW ** -0.5,
        "lru_bx": 0.01 * nrm(ks[11], (DEPTH, 2, W_LRU), f32),
        "lru_lambda": jnp.log(a0) - jnp.log1p(-a0),
        "rpb": 0.1 * nrm(ks[13], (DEPTH, N_HEADS, 2 * WIN_R - 1, 2 * WIN_C - 1), f32),
        "gn_lru": 1.0 + 0.01 * nrm(ks[14], (DEPTH, W_LRU), f32),
        "gn_att": 1.0 + 0.01 * nrm(ks[15], (DEPTH, W_ATT), f32),
        "w_out": nrm(ks[16], (DEPTH, D_MIX, D_MODEL), f32) * D_MIX ** -0.5,
        "final_g": 1.0 + 0.01 * nrm(ks[17], (D_MODEL,), f32),
    }


def reference(x, c, norm_g, w_ada, b_ada, w_in, conv_w, conv_b, lru_wa, lru_ba, lru_wx,
              lru_bx, lru_lambda, rpb, gn_lru, gn_att, w_out, final_g):
    cond = jax.nn.silu(c)
    for l in range(DEPTH):
        x = hybrid_layer(x, cond, norm_g[l], w_ada[l], b_ada[l], w_in[l], conv_w[l], conv_b[l],
                         lru_wa[l], lru_ba[l], lru_wx[l], lru_bx[l], lru_lambda[l], rpb[l],
                         gn_lru[l], gn_att[l], w_out[l])
    return rms_norm(x, final_g)
```

```cpp
#include <hip/hip_runtime.h>
#include <cstdio>
#include <cstdint>

namespace pg8 {
#define PG8_LAS __attribute__((address_space(3)))
typedef unsigned short bf16_t;
typedef short bf16x8 __attribute__((ext_vector_type(8)));
typedef float f32x4 __attribute__((ext_vector_type(4)));
typedef unsigned u32x4 __attribute__((ext_vector_type(4)));
constexpr int BM = 256, BK = 64, HALF = 128, HTB = HALF * BK * 2  , STAGE_BYTES = 8 * HTB, NXCD = 8;
#ifndef PG8_WGM
#define PG8_WGM 8
#endif
constexpr int WGM = PG8_WGM;

__host__ __device__ __forceinline__ int lds_byte(int r, int c) { const int st = (r >> 4) * 2 + (c >> 5), rr = r & 15, cc = c & 31, ob = rr * 64 + cc * 2; return st * 1024 + (ob ^ (((ob >> 9) & 1) << 5)); }
__host__ __device__ __forceinline__ void stage_rc(int b, int& R, int& C) { const int st = b / 1024, sb = b % 1024, swz = sb ^ (((sb >> 9) & 1) << 5); R = (st >> 1) * 16 + swz / 64; C = (st & 1) * 32 + (swz % 64) / 2; }
__host__ __device__ __forceinline__ int perm32(int rho) { const int n = rho >> 4, i = rho & 15; return 8 * (i >> 2) + 4 * n + (i & 3); }

struct Unit { int pm, pn; };
struct Gemm { const bf16_t* A; const bf16_t* Bt; int M, N, K; };

struct StaticOrder {
    int nM, nN, nwg, G, c;
    __host__ __device__ void init(int M, int N, int G_, int c_) { nM = M / BM; nN = N / BM; nwg = nM * nN; G = G_; c = c_; }
    __host__ __device__ bool next(int i, Unit& u) const {
        const long L = (long)i * G + c; if (L >= nwg) return false;
        int wgid = (int)L; { const int q = nwg / NXCD, r = nwg % NXCD, xcd = wgid % NXCD, off = wgid / NXCD; wgid = (xcd < r ? xcd * (q + 1) : r * (q + 1) + (xcd - r) * q) + off; }
        const int nig = WGM * nN, gid = wgid / nig, fm = gid * WGM, gsz = (nM - fm) < WGM ? (nM - fm) : WGM;
        u.pm = fm + ((wgid % nig) % gsz); u.pn = (wgid % nig) / gsz; return true;
    }
    __device__ __forceinline__ void a_ready(const Unit&) const {}
    __device__ __forceinline__ void done(const Unit&) const {}
};

__device__ __forceinline__ unsigned cvt_pk_bf16(float lo, float hi) { unsigned r; asm volatile("v_cvt_pk_bf16_f32 %0, %1, %2" : "=v"(r) : "v"(lo), "v"(hi)); return r; }
typedef float f32x2 __attribute__((ext_vector_type(2)));

struct EpiBf16N {
    static constexpr bool PERM = true, AFTER_DRAIN = false, MIDK = false;
    bf16_t* O; int ldc; const float* sw; int swpitch; const PG8_LAS float* rtab;
    __device__ __forceinline__ void operator()(const f32x4 (&acc)[2][2][4][2], const Unit& u, int wr, int wc, int fr, int fq) const {
        const int row0 = u.pm * BM + wr * 64 + fr; const int col0 = u.pn * BM + wc * 32 + 8 * fq;
        const float* swp = sw + (size_t)((u.pm * BM) >> 12) * swpitch + col0;
        f32x4 sv[2][2];
#pragma unroll
        for (int bj = 0; bj < 2; ++bj)
#pragma unroll
            for (int n = 0; n < 2; ++n) sv[bj][n] = *(const f32x4*)(swp + bj * HALF + 4 * n);
#pragma unroll
        for (int ai = 0; ai < 2; ++ai)
#pragma unroll
            for (int m = 0; m < 4; ++m) { bf16_t* rowp = O + ((size_t)(2 * u.pn) * ldc + (row0 + ai * HALF + m * 16)) * 128 + (wc * 32 + 8 * fq); const float rs = rtab[ai * HALF + wr * 64 + m * 16 + fr];
#pragma unroll
                for (int bj = 0; bj < 2; ++bj) { const f32x4 v0 = acc[ai][bj][m][0] * rs + sv[bj][0], v1 = acc[ai][bj][m][1] * rs + sv[bj][1];
                    u32x4 w; w.x = cvt_pk_bf16(v0[0], v0[1]); w.y = cvt_pk_bf16(v0[2], v0[3]); w.z = cvt_pk_bf16(v1[0], v1[1]); w.w = cvt_pk_bf16(v1[2], v1[3]);
                    *(u32x4*)(rowp + (size_t)bj * ldc * 128) = w;
                    } }
    }
};
constexpr int M_ROWS = 8192;
struct EpiResid {
    static constexpr bool PERM = true, AFTER_DRAIN = false, MIDK = true;
    const float* xin; float* xout; int ldc; const float* gate; int gpitch; const PG8_LAS float* rtab;
    const bf16_t* xin16; bf16_t* xout16;
    bf16_t* hn; const float* gnext; const float* sclnext; int spitch; float* rs;
    __device__ __forceinline__ void midk(f32x4 (&acc)[2][2][4][2], const Unit& u, int wr, int fr) const {
#pragma unroll
        for (int ai = 0; ai < 2; ++ai)
#pragma unroll
            for (int m = 0; m < 4; ++m) { const float s = rtab[ai * HALF + wr * 64 + m * 16 + fr];
#pragma unroll
                for (int bj = 0; bj < 2; ++bj)
#pragma unroll
                    for (int n = 0; n < 2; ++n) acc[ai][bj][m][n] *= s; }
    }
    __device__ __forceinline__ void operator()(const f32x4 (&acc)[2][2][4][2], const Unit& u, int wr, int wc, int fr, int fq) const {
        const int row0 = u.pm * BM + wr * 64 + fr, col0 = u.pn * BM + wc * 32 + 8 * fq;
        const float* gp = gate + (size_t)((u.pm * BM) >> 12) * gpitch + col0;
        f32x4 gv[2][2], gs[2][2];
        const bool nx = (hn != nullptr);
#pragma unroll
        for (int bj = 0; bj < 2; ++bj)
#pragma unroll
            for (int n = 0; n < 2; ++n) { gv[bj][n] = *(const f32x4*)(gp + bj * HALF + 4 * n);
                gs[bj][n] = (f32x4){0.f, 0.f, 0.f, 0.f};
                if (nx) gs[bj][n] = *(const f32x4*)(gnext + col0 + bj * HALF + 4 * n) * (*(const f32x4*)(sclnext + (size_t)((u.pm * BM) >> 12) * spitch + col0 + bj * HALF + 4 * n) + 1.0f); }
#ifndef XW_DEPTH
#define XW_DEPTH 0
#endif
#pragma unroll
        for (int ai = 0; ai < 2; ++ai) {
            u32x4 xw[4][2];
            if (xin16) {
#pragma unroll
                for (int m = 0; m < XW_DEPTH; ++m)
#pragma unroll
                    for (int bj = 0; bj < 2; ++bj) xw[m][bj] = *(const u32x4*)(xin16 + ((size_t)((col0 + bj * HALF) >> 6) * M_ROWS + (row0 + ai * HALF + m * 16)) * 64 + ((col0 + bj * HALF) & 63));
            }
#pragma unroll
            for (int m = 0; m < 4; ++m) {
                const size_t off = (size_t)(row0 + ai * HALF + m * 16) * ldc + col0; float q = 0.f;
                const float ra = rtab[256 + ai * HALF + wr * 64 + m * 16 + fr];
                f32x4 xi[2][2];
                if (xin16) {
#pragma unroll
                    for (int bj = 0; bj < 2; ++bj) { u32x4 w;
                        if (m < XW_DEPTH) w = xw[m][bj]; else w = *(const u32x4*)(xin16 + ((size_t)((col0 + bj * HALF) >> 6) * M_ROWS + (row0 + ai * HALF + m * 16)) * 64 + ((col0 + bj * HALF) & 63));
                        xi[bj][0] = (f32x4){__builtin_bit_cast(float, w.x << 16), __builtin_bit_cast(float, w.x & 0xffff0000u), __builtin_bit_cast(float, w.y << 16), __builtin_bit_cast(float, w.y & 0xffff0000u)};
                        xi[bj][1] = (f32x4){__builtin_bit_cast(float, w.z << 16), __builtin_bit_cast(float, w.z & 0xffff0000u), __builtin_bit_cast(float, w.w << 16), __builtin_bit_cast(float, w.w & 0xffff0000u)}; }
                } else {
#pragma unroll
                    for (int bj = 0; bj < 2; ++bj)
#pragma unroll
                        for (int n = 0; n < 2; ++n) xi[bj][n] = *(const f32x4*)(xin + off + bj * HALF + 4 * n);
                }
#pragma unroll
                for (int bj = 0; bj < 2; ++bj) { f32x4 xo[2];
#pragma unroll
                    for (int n = 0; n < 2; ++n) xo[n] = xi[bj][n] + gv[bj][n] * (acc[ai][bj][m][n] * ra);
                    if (xout16) { u32x4 w; w.x = cvt_pk_bf16(xo[0][0], xo[0][1]); w.y = cvt_pk_bf16(xo[0][2], xo[0][3]); w.z = cvt_pk_bf16(xo[1][0], xo[1][1]); w.w = cvt_pk_bf16(xo[1][2], xo[1][3]);
                        *(u32x4*)(xout16 + ((size_t)((col0 + bj * HALF) >> 6) * M_ROWS + (row0 + ai * HALF + m * 16)) * 64 + ((col0 + bj * HALF) & 63)) = w; }
                    else { *(f32x4*)(xout + off + bj * HALF) = xo[0]; *(f32x4*)(xout + off + bj * HALF + 4) = xo[1]; }
                    if (nx) { q += ((xo[0][0] * xo[0][0] + xo[0][1] * xo[0][1]) + (xo[0][2] * xo[0][2] + xo[0][3] * xo[0][3])) + ((xo[1][0] * xo[1][0] + xo[1][1] * xo[1][1]) + (xo[1][2] * xo[1][2] + xo[1][3] * xo[1][3]));
                        const f32x4 h0 = xo[0] * gs[bj][0], h1 = xo[1] * gs[bj][1];
                        u32x4 w; w.x = cvt_pk_bf16(h0[0], h0[1]); w.y = cvt_pk_bf16(h0[2], h0[3]); w.z = cvt_pk_bf16(h1[0], h1[1]); w.w = cvt_pk_bf16(h1[2], h1[3]);
                        *(u32x4*)(hn + ((size_t)((col0 + bj * HALF) >> 6) * M_ROWS + (row0 + ai * HALF + m * 16)) * 64 + ((col0 + bj * HALF) & 63)) = w; } }
                if (nx) { q += __shfl_xor(q, 16); q += __shfl_xor(q, 32);
                    if (fq == 0) rs[(size_t)(row0 + ai * HALF + m * 16) * 64 + u.pn * 4 + wc] = q; }
                asm volatile("" ::: "memory"); } }
    }
};


template <class Epi, class Sched, bool ALIGN_EPI = false, bool SP2 = false>
__device__ __forceinline__ void gemm_phase(PG8_LAS unsigned char* lds, const Gemm g, const Sched& S, const Epi& E) {
    int tid_ = threadIdx.x; asm volatile("" : "+v"(tid_));
    const int tid = tid_, wid = __builtin_amdgcn_readfirstlane(tid >> 6), lane = tid & 63, wr = wid >> 2, wc = wid & 3, fr = lane & 15, fq = lane >> 4;
    const int K = g.K, nt = K / BK;
    unsigned voffA[2], voffB[2];
#pragma unroll
    for (int i = 0; i < 2; ++i) { int R, C; stage_rc(tid * 16 + i * 8192, R, C); const int Rb = Epi::PERM ? ((R & ~31) + perm32(R & 31)) : R;
        voffA[i] = (unsigned)(R * BK + C) * 2u; voffB[i] = (unsigned)(Rb * BK + C) * 2u; }
    const size_t kstepB = (size_t)g.N * BK * 2, hstepB = (size_t)HALF * BK * 2, tstepB = 2 * hstepB;
    const size_t kstepA = (size_t)g.M * BK * 2, hstepA = hstepB, tstepA = tstepB;
    const unsigned ldsw = (unsigned)wid * 1024u;
    const int aoff = lds_byte(wr * 64 + fr, fq * 8), boff = lds_byte(wc * 32 + fr, fq * 8);
#define PG8_SA(b, h) (((b) * 2 + (h)) * HTB)
#define PG8_SB(b, h) ((4 + (b) * 2 + (h)) * HTB)
#define PG8_STAGE(bufoff, gbase, voff) do { _Pragma("unroll") for (int _i = 0; _i < 2; ++_i) \
        __builtin_amdgcn_global_load_lds((const unsigned*)((const char*)(gbase) + (voff)[_i]), (PG8_LAS unsigned*)(lds + (bufoff) + ldsw + _i * 8192), 16, 0, 0); } while (0)
#define PG8_LDA(dst, b, h) do { _Pragma("unroll") for (int m = 0; m < 4; ++m) _Pragma("unroll") for (int k = 0; k < 2; ++k) dst[m][k] = *(const PG8_LAS bf16x8*)(lds + PG8_SA(b, h) + aoff + m * 2048 + k * 1024); } while (0)
#define PG8_LDB(dst, b, h) do { _Pragma("unroll") for (int n = 0; n < 2; ++n) _Pragma("unroll") for (int k = 0; k < 2; ++k) dst[n][k] = *(const PG8_LAS bf16x8*)(lds + PG8_SB(b, h) + boff + n * 2048 + k * 1024); } while (0)
#define PG8_MMA(ai, bj, At, Bt) do { __builtin_amdgcn_s_setprio(1); _Pragma("unroll") for (int m = 0; m < 4; ++m) _Pragma("unroll") for (int n = 0; n < 2; ++n) _Pragma("unroll") for (int k = 0; k < 2; ++k) \
        acc[ai][bj][m][n] = __builtin_amdgcn_mfma_f32_16x16x32_bf16(Bt[n][k], At[m][k], acc[ai][bj][m][n], 0, 0, 0); __builtin_amdgcn_s_setprio(0); } while (0)
#define PG8_WAIT_V(n) asm volatile("s_waitcnt vmcnt(" #n ")" ::: "memory")
#define PG8_WAIT_L(n) asm volatile("s_waitcnt lgkmcnt(" #n ")" ::: "memory")
#define PG8_BAR __builtin_amdgcn_s_barrier()
#define PG8_SCHED __builtin_amdgcn_sched_barrier(0)
    Unit cur, nxt; int ui = 0;
    if (!S.next(0, cur)) return;
    f32x4 acc[2][2][4][2];
#pragma unroll
    for (int a = 0; a < 2; ++a)
#pragma unroll
        for (int b = 0; b < 2; ++b)
#pragma unroll
            for (int m = 0; m < 4; ++m)
#pragma unroll
                for (int n = 0; n < 2; ++n) acc[a][b][m][n] = (f32x4){0.f, 0.f, 0.f, 0.f};
    bf16x8 At[4][2], B0[2][2], B1[2][2];
    const char* cA = (const char*)g.A + (size_t)cur.pm * tstepA; const char* cB = (const char*)g.Bt + (size_t)cur.pn * tstepB;
    S.a_ready(cur);
    if constexpr (SP2) {
        PG8_STAGE(PG8_SB(0, 0), cB, voffB); PG8_STAGE(PG8_SB(0, 1), cB + hstepB, voffB); PG8_STAGE(PG8_SA(0, 0), cA, voffA); PG8_STAGE(PG8_SA(0, 1), cA + hstepA, voffA);
        if (wr == 1) PG8_BAR;
        PG8_WAIT_V(2); PG8_BAR;
        PG8_STAGE(PG8_SB(1, 0), cB + kstepB, voffB); PG8_STAGE(PG8_SA(1, 0), cA + kstepA, voffA); PG8_STAGE(PG8_SB(1, 1), cB + hstepB + kstepB, voffB);
        PG8_WAIT_V(6); PG8_BAR;
    } else {
        PG8_STAGE(PG8_SB(0, 0), cB, voffB); PG8_STAGE(PG8_SA(0, 0), cA, voffA); PG8_STAGE(PG8_SB(0, 1), cB + hstepB, voffB); PG8_STAGE(PG8_SA(0, 1), cA + hstepA, voffA);
        if (wr == 1) PG8_BAR;
        PG8_WAIT_V(4); PG8_BAR;
        PG8_STAGE(PG8_SB(1, 0), cB + kstepB, voffB); PG8_STAGE(PG8_SA(1, 0), cA + kstepA, voffA); PG8_STAGE(PG8_SB(1, 1), cB + hstepB + kstepB, voffB);
        PG8_WAIT_V(6); PG8_BAR;
    }
    for (;;) {
        const bool has_next = S.next(ui + 1, nxt);
        const char* nA = has_next ? (const char*)g.A + (size_t)nxt.pm * tstepA : cA; const char* nB = has_next ? (const char*)g.Bt + (size_t)nxt.pn * tstepB : cB;
        for (int t = 0; t < nt; t += 2) {
            const bool last = (t == nt - 2);
            const char* a1 = cA + (size_t)(t + 1) * kstepA;
            const char* a2 = last ? nA : cA + (size_t)(t + 2) * kstepA; const char* b2 = last ? nB : cB + (size_t)(t + 2) * kstepB;
            const char* a3 = a2 + kstepA; const char* b3 = b2 + kstepB;
            if (last && has_next) S.a_ready(nxt);
            if constexpr (Epi::MIDK) { if (t == nt / 2) E.midk(acc, cur, wr, fr); }
            if constexpr (SP2) {
            PG8_LDB(B0, 0, 0); PG8_LDB(B1, 0, 1); PG8_SCHED; PG8_LDA(At, 0, 0); PG8_STAGE(PG8_SA(1, 1), a1 + hstepA, voffA);
            PG8_WAIT_V(8); PG8_WAIT_L(0); PG8_BAR; PG8_MMA(0, 0, At, B0); PG8_MMA(0, 1, At, B1); PG8_BAR; PG8_SCHED;
            PG8_LDA(At, 0, 1); PG8_STAGE(PG8_SB(0, 0), b2, voffB); PG8_STAGE(PG8_SB(0, 1), b2 + hstepB, voffB); PG8_STAGE(PG8_SA(0, 0), a2, voffA);
            PG8_WAIT_V(8); PG8_WAIT_L(0); PG8_BAR; PG8_MMA(1, 0, At, B0); PG8_MMA(1, 1, At, B1); PG8_BAR; PG8_SCHED;
            PG8_LDB(B0, 1, 0); PG8_LDB(B1, 1, 1); PG8_SCHED; PG8_LDA(At, 1, 0); PG8_STAGE(PG8_SA(0, 1), a2 + hstepA, voffA);
            PG8_WAIT_V(8); PG8_WAIT_L(0); PG8_BAR; PG8_MMA(0, 0, At, B0); PG8_MMA(0, 1, At, B1); PG8_BAR; PG8_SCHED;
            PG8_LDA(At, 1, 1); PG8_STAGE(PG8_SB(1, 0), b3, voffB); PG8_STAGE(PG8_SB(1, 1), b3 + hstepB, voffB); PG8_STAGE(PG8_SA(1, 0), a3, voffA);
            PG8_WAIT_V(8); PG8_WAIT_L(0); PG8_BAR; PG8_MMA(1, 0, At, B0); PG8_MMA(1, 1, At, B1); PG8_BAR; PG8_SCHED;
            } else {
            PG8_LDB(B0, 0, 0); PG8_SCHED; PG8_LDA(At, 0, 0); PG8_STAGE(PG8_SA(1, 1), a1 + hstepA, voffA);
            PG8_WAIT_L(8); PG8_BAR; PG8_WAIT_L(0); PG8_MMA(0, 0, At, B0); PG8_BAR; PG8_SCHED;
            PG8_LDB(B1, 0, 1); PG8_STAGE(PG8_SB(0, 0), b2, voffB);
            PG8_BAR; PG8_WAIT_L(0); PG8_MMA(0, 1, At, B1); PG8_BAR;
            PG8_LDA(At, 0, 1); PG8_STAGE(PG8_SA(0, 0), a2, voffA);
            PG8_BAR; PG8_WAIT_L(0); PG8_MMA(1, 0, At, B0); PG8_BAR; PG8_SCHED;
            PG8_STAGE(PG8_SB(0, 1), b2 + hstepB, voffB);
            PG8_WAIT_V(6); PG8_BAR; PG8_MMA(1, 1, At, B1); PG8_BAR;
            PG8_LDB(B0, 1, 0); PG8_SCHED; PG8_LDA(At, 1, 0); PG8_STAGE(PG8_SA(0, 1), a2 + hstepA, voffA);
            PG8_WAIT_L(8); PG8_BAR; PG8_WAIT_L(0); PG8_MMA(0, 0, At, B0); PG8_BAR; PG8_SCHED;
            PG8_LDB(B1, 1, 1); PG8_STAGE(PG8_SB(1, 0), b3, voffB);
            PG8_BAR; PG8_WAIT_L(0); PG8_MMA(0, 1, At, B1); PG8_BAR;
            PG8_LDA(At, 1, 1); PG8_STAGE(PG8_SA(1, 0), a3, voffA);
            PG8_BAR; PG8_WAIT_L(0); PG8_MMA(1, 0, At, B0); PG8_BAR; PG8_SCHED;
            PG8_STAGE(PG8_SB(1, 1), b3 + hstepB, voffB);
            PG8_WAIT_V(6); PG8_BAR; PG8_MMA(1, 1, At, B1); PG8_BAR;
            }
        }
        if constexpr (ALIGN_EPI) { if (wr == 0) PG8_BAR; }
        if constexpr (!Epi::AFTER_DRAIN) { E(acc, cur, wr, wc, fr, fq); S.done(cur); }
        if (!has_next) break;
#pragma unroll
        for (int a = 0; a < 2; ++a)
#pragma unroll
            for (int b = 0; b < 2; ++b)
#pragma unroll
                for (int m = 0; m < 4; ++m)
#pragma unroll
                    for (int n = 0; n < 2; ++n) acc[a][b][m][n] = (f32x4){0.f, 0.f, 0.f, 0.f};
        cur = nxt; cA = nA; cB = nB; ++ui;
        if constexpr (ALIGN_EPI) { if (wr == 1) PG8_BAR; }
    }
    PG8_WAIT_V(0);
    if constexpr (!ALIGN_EPI) { if (wr == 0) PG8_BAR; }
    PG8_BAR;
    if constexpr (Epi::AFTER_DRAIN) { E.fused(acc, cur, wr, wc, fr, fq, lds, wid, lane); S.done(cur); }
#undef PG8_SA
#undef PG8_SB
#undef PG8_STAGE
#undef PG8_LDA
#undef PG8_LDB
#undef PG8_MMA
#undef PG8_WAIT_V
#undef PG8_WAIT_L
#undef PG8_BAR
#undef PG8_SCHED
}
}

#ifndef PG8_SP2
#define PG8_SP2 true
#endif
#ifndef PG8_ALIGN
#define PG8_ALIGN true
#endif

constexpr int NWAVES = 8;
constexpr int D = 4096, BATCH = 2, SEQ = 4096, DEPTH = 4, M = BATCH * SEQ;
constexpr int WL = 2048, WA = 2048, NBLK = 16, BW = 128, NH = 16, HD = 128, GW = 64, ROWS = 64, KR = 8, KC = 16;
constexpr int DIN = 2 * WL + 4 * WA;
constexpr int PP = DIN + 128;
constexpr int OFF_XA = 0, OFF_GA = WL, OFF_Q = 2 * WL, OFF_K = 2 * WL + WA, OFF_V = 2 * WL + 2 * WA, OFF_GB = 2 * WL + 3 * WA;
constexpr float EPS = 1e-6f, C_RG = 8.0f;
constexpr int TC = 64, NCH = SEQ / TC;

constexpr size_t MiB = 1u << 20;
constexpr size_t WS_CTL = 0, CTL_ZERO_BYTES = 1 * MiB;
constexpr size_t WS_MOD = 1 * MiB;
constexpr size_t WS_SW = 1 * MiB + 512 * 1024;
constexpr size_t WS_WAT = 2 * MiB, WS_WXT = 6 * MiB;
constexpr size_t WS_WIN = 16 * MiB;
constexpr size_t WS_WOUT = 400 * MiB;
constexpr size_t WS_H = 528 * MiB;
constexpr size_t WS_P = 1088 * MiB;
constexpr size_t WS_YC = 784 * MiB;
constexpr size_t WS_LH = 848 * MiB, WS_PF = 912 * MiB, WS_PB = 976 * MiB;
constexpr size_t WS_SUM = 1040 * MiB;
constexpr size_t WS_CAR = 1048 * MiB;
constexpr size_t WS_YB = 1052 * MiB;
constexpr size_t WS_SSQ = 1084 * MiB;
constexpr size_t WS_SSA = 1085 * MiB + 512 * 1024;
constexpr size_t WS_XB = 1284 * MiB;
constexpr size_t WS_RS = 1086 * MiB;
constexpr size_t WS_END = 1348 * MiB;
static_assert(WS_SUM + (size_t)BATCH * NCH * 2 * WL * 2 * 4 <= WS_CAR && WS_CAR + (size_t)BATCH * NCH * 2 * WL * 4 <= WS_YB && WS_YB + (size_t)M * WA * 2 <= WS_SSQ && WS_SSQ + (size_t)M * NH * 4 <= WS_END, "d_ws map (scan scratch)");
static_assert(WS_MOD + (size_t)DEPTH * 2 * 3 * D * 4 <= WS_SW && WS_SW + (size_t)DEPTH * 2 * DIN * 4 <= WS_WAT && WS_WAT + (size_t)DEPTH * 2 * NBLK * BW * BW * 2 <= WS_WXT && WS_WXT + (size_t)DEPTH * 2 * NBLK * BW * BW * 2 <= WS_WIN, "d_ws map (small)");
static_assert(WS_WIN + (size_t)DEPTH * DIN * D * 2 <= WS_WOUT && WS_WOUT + (size_t)DEPTH * D * D * 2 <= WS_H && WS_H + (size_t)M * D * 2 <= WS_YC && WS_P + (size_t)M * PP * 2 <= WS_END && WS_YC + (size_t)M * D * 2 <= WS_LH, "d_ws map (big)");
static_assert(WS_LH + (size_t)M * WL * 4 <= WS_PF && WS_PF + (size_t)M * WL * 4 <= WS_PB && WS_PB + (size_t)M * WL * 4 <= WS_SUM, "d_ws map (lru)");
constexpr int CW_TMO = 0, CW_CODE = 1;
constexpr int CW_CARRY = 1024;
constexpr int CW_CREADY = 3072;
constexpr int CW_RANK = 2048;
constexpr int CW_BAR = 4096;

constexpr int RING_OFF = 0, RING_BYTES = 131072;
constexpr int LDS_BYTES = 147456;
constexpr int LDSCTL_OFF = LDS_BYTES - 3072, MISC_OFF = LDSCTL_OFF + 320;
constexpr int RTAB_OFF = LDSCTL_OFF + 1024;
constexpr int PHASE_LDS = LDSCTL_OFF;
static_assert(RING_BYTES <= PHASE_LDS && MISC_OFF + 128 <= RTAB_OFF && RTAB_OFF + 2048 <= LDS_BYTES, "LDS map");

#define GAS __attribute__((address_space(1)))
#define LAS __attribute__((address_space(3)))
typedef unsigned short bf16;
typedef unsigned v4u __attribute__((ext_vector_type(4)));
typedef unsigned v2u __attribute__((ext_vector_type(2)));
typedef float f32x4 __attribute__((ext_vector_type(4)));
typedef short bf16x8 __attribute__((ext_vector_type(8)));
typedef GAS unsigned gu32;
typedef GAS unsigned long long gu64;
#define RLX_AGENT __ATOMIC_RELAXED, __HIP_MEMORY_SCOPE_AGENT
#define LDS_WAIT() asm volatile("s_waitcnt lgkmcnt(0)" ::: "memory")
#define VM_WAIT() asm volatile("s_waitcnt vmcnt(0)" ::: "memory")
__device__ __forceinline__ unsigned f2bf(float f) { unsigned u = __builtin_bit_cast(unsigned, f); return (u + 0x7fffu + ((u >> 16) & 1u)) >> 16; }
typedef float f32x2_t __attribute__((ext_vector_type(2))); typedef __bf16 bf16x2_t __attribute__((ext_vector_type(2)));
__device__ __forceinline__ unsigned pk2(float lo, float hi) { const f32x2_t v = {lo, hi}; return __builtin_bit_cast(unsigned, __builtin_convertvector(v, bf16x2_t)); }
__device__ __forceinline__ size_t a_tiled(size_t row, int col) { return ((size_t)(col >> 6) * M + row) * 64 + (col & 63); }
__device__ __forceinline__ size_t p_idx(size_t tok, int col) { return ((size_t)(col >> 7) * M + tok) * 128 + (col & 127); }
__device__ __forceinline__ float bf2f(unsigned short b) { return __builtin_bit_cast(float, ((unsigned)b) << 16); }
__device__ __forceinline__ float bflo(unsigned w) { return __builtin_bit_cast(float, w << 16); }
__device__ __forceinline__ float bfhi(unsigned w) { return __builtin_bit_cast(float, w & 0xffff0000u); }
__device__ __forceinline__ float sigmoidf_(float v) { return 1.0f / (1.0f + __expf(-v)); }
__device__ __forceinline__ float siluf_(float v) { return v / (1.0f + __expf(-v)); }


#define XB_TMO      128
#define XB_XCNT(j)  (256  + 64 * (j))
#define XB_XSUB(j)  (1280 + 64 * (j))
#define XB_XGEN(j)  (2304 + 64 * (j))
#define XB_TOP      3328
#define XB_TOPGEN   3392
#define XCD_BAR_WORDS 3456
#define XB_SPIN_CAP (1u << 18)

__device__ __forceinline__ unsigned xb_ld(unsigned* p)              { return __hip_atomic_load(p, __ATOMIC_RELAXED, __HIP_MEMORY_SCOPE_AGENT); }
__device__ __forceinline__ unsigned xb_add(unsigned* p, unsigned v) { return __hip_atomic_fetch_add(p, v, __ATOMIC_RELAXED, __HIP_MEMORY_SCOPE_AGENT); }
__device__ __forceinline__ unsigned xb_xcc_id() { return (unsigned)__builtin_amdgcn_s_getreg((3 << 11) | 20) & 0xFu; }
#define XB_SPIN(cond, bar) do { unsigned _sp = 0; while (cond) { __builtin_amdgcn_s_sleep(1); \
    if ((++_sp & 255u) == 0u) { if (xb_ld(&(bar)[XB_TMO])) break; if (_sp > XB_SPIN_CAP) { atomicAdd(&(bar)[XB_TMO], 1u); break; } } } } while (0)

struct XcdBarrier {
    unsigned* bar; unsigned x;
    volatile LAS unsigned* st;
};

__device__ __forceinline__ XcdBarrier xcd_barrier_post(unsigned* bar, volatile LAS unsigned* st) {
    XcdBarrier b; b.bar = bar; b.x = xb_xcc_id(); b.st = st;
    if (threadIdx.x == 0) (void)xb_add(&bar[XB_XCNT(b.x)], 1u);
    return b;
}
__device__ __forceinline__ void xcd_barrier_complete(unsigned* bar, unsigned x, unsigned& nloc, unsigned& nx) {
    const unsigned G = gridDim.x * gridDim.y * gridDim.z;
    unsigned sum, cnt, mine, sp = 0u;
    for (;;) {
        sum = 0u; cnt = 0u; mine = 0u;
#pragma unroll
        for (unsigned j = 0; j < 16; ++j) { const unsigned c = xb_ld(&bar[XB_XCNT(j)]); sum += c; cnt += (c > 0u) ? 1u : 0u; mine = (j == x) ? c : mine; }
        if (sum == G) break;
        __builtin_amdgcn_s_sleep(1);
        if ((++sp & 255u) == 0u) { if (xb_ld(&bar[XB_TMO])) break; if (sp > XB_SPIN_CAP) { atomicAdd(&bar[XB_TMO], 1u); break; } }
    }
    nloc = mine > 0u ? mine : 1u; nx = cnt > 0u ? cnt : 1u;
}

__device__ __forceinline__ void xcd_barrier(const XcdBarrier& b) {
    asm volatile("s_waitcnt vmcnt(0)" ::: "memory");
    __syncthreads();
    if (threadIdx.x == 0) {
        unsigned* bar = b.bar;
        __builtin_amdgcn_s_waitcnt(0);
        unsigned nloc = b.st[0], nx = b.st[1];
        if (nloc == 0u) { xcd_barrier_complete(bar, b.x, nloc, nx); b.st[0] = nloc; b.st[1] = nx; }
        const unsigned old = xb_add(&bar[XB_XSUB(b.x)], 1u);
        const unsigned gen = old / nloc;
        if (old + 1u == (gen + 1u) * nloc) {
            __builtin_amdgcn_fence(__ATOMIC_RELEASE, "agent");
            asm volatile("s_waitcnt vmcnt(0)" ::: "memory");
            const unsigned og = xb_add(&bar[XB_TOP], 1u);
            const unsigned tg = og / nx;
            if (og + 1u == (tg + 1u) * nx) xb_add(&bar[XB_TOPGEN], 1u);
            else XB_SPIN(xb_ld(&bar[XB_TOPGEN]) == tg, bar);
            __builtin_amdgcn_fence(__ATOMIC_ACQUIRE, "agent");
            xb_add(&bar[XB_XGEN(b.x)], 1u);
            asm volatile("s_waitcnt vmcnt(0)" ::: "memory");
        } else {
            XB_SPIN(xb_ld(&bar[XB_XGEN(b.x)]) == gen, bar);
            __builtin_amdgcn_fence(__ATOMIC_ACQUIRE, "agent");
            asm volatile("s_waitcnt vmcnt(0)" ::: "memory");
        }
    }
    __syncthreads();
}


struct Args { const float* in[18]; float* out; unsigned char* ws; int ph_lo, ph_hi, li, pad; };
typedef const __attribute__((address_space(4))) Args* KArgs;
struct Frame {
    LAS unsigned char* lds;
    volatile LAS unsigned* MISC;
    int tid, lane, wave;
    int vcu, G, cid;
};
#define F_x          (A->in[0])
#define F_c          (A->in[1])
#define F_norm_g     (A->in[2])
#define F_w_ada      (A->in[3])
#define F_b_ada      (A->in[4])
#define F_w_in       (A->in[5])
#define F_conv_w     (A->in[6])
#define F_conv_b     (A->in[7])
#define F_lru_wa     (A->in[8])
#define F_lru_ba     (A->in[9])
#define F_lru_wx     (A->in[10])
#define F_lru_bx     (A->in[11])
#define F_lru_lambda (A->in[12])
#define F_rpb        (A->in[13])
#define F_gn_lru     (A->in[14])
#define F_gn_att     (A->in[15])
#define F_w_out      (A->in[16])
#define F_final_g    (A->in[17])
#define F_out        (A->out)
#define F_ctl        ((gu32*)(A->ws + WS_CTL))
#define F_MOD        ((float*)(A->ws + WS_MOD))
#define F_WAT        ((bf16*)(A->ws + WS_WAT))
#define F_WXT        ((bf16*)(A->ws + WS_WXT))
#define F_WIN        ((bf16*)(A->ws + WS_WIN))
#define F_WOUT       ((bf16*)(A->ws + WS_WOUT))
#define F_HB         ((bf16*)(A->ws + WS_H))
#define F_PB         ((bf16*)(A->ws + WS_P))
#define F_YC         ((bf16*)(A->ws + WS_YC))
#define F_YB         ((bf16*)(A->ws + WS_YB))
#define F_LH         ((bf16*)(A->ws + WS_LH))
#define F_PF         ((bf16*)(A->ws + WS_PF))
#define F_PBK        ((bf16*)(A->ws + WS_PB))
#define F_SUM        ((float*)(A->ws + WS_SUM))
#define F_CAR        ((float*)(A->ws + WS_CAR))
#define F_SSQ        ((float*)(A->ws + WS_SSQ))
#define F_SSA        ((float*)(A->ws + WS_SSA))
#define F_SW         ((float*)(A->ws + WS_SW))
#define F_XB         ((bf16*)(A->ws + WS_XB))
#define F_RS         ((float*)(A->ws + WS_RS))

__device__ __forceinline__ float wave_sum(float v) {
#pragma unroll
    for (int o = 1; o < 64; o <<= 1) v += __shfl_xor(v, o);
    return v;
}


__device__ __forceinline__ int launder_v(int v) { asm volatile("" : "+v"(v)); return v; }
__device__ __forceinline__ float xor16_max(float x) { const auto s = __builtin_amdgcn_permlane16_swap(__builtin_bit_cast(unsigned, x), __builtin_bit_cast(unsigned, x), false, false);
    const unsigned s0 = s[0], s1 = s[1]; return fmaxf(__builtin_bit_cast(float, s0), __builtin_bit_cast(float, s1)); }
__device__ __forceinline__ float xor32_max(float x) { const auto s = __builtin_amdgcn_permlane32_swap(__builtin_bit_cast(unsigned, x), __builtin_bit_cast(unsigned, x), false, false);
    const unsigned s0 = s[0], s1 = s[1]; return fmaxf(__builtin_bit_cast(float, s0), __builtin_bit_cast(float, s1)); }
__device__ __forceinline__ float xor16_sum(float x) { const auto s = __builtin_amdgcn_permlane16_swap(__builtin_bit_cast(unsigned, x), __builtin_bit_cast(unsigned, x), false, false);
    const unsigned s0 = s[0], s1 = s[1]; return __builtin_bit_cast(float, s0) + __builtin_bit_cast(float, s1); }
__device__ __forceinline__ float xor32_sum(float x) { const auto s = __builtin_amdgcn_permlane32_swap(__builtin_bit_cast(unsigned, x), __builtin_bit_cast(unsigned, x), false, false);
    const unsigned s0 = s[0], s1 = s[1]; return __builtin_bit_cast(float, s0) + __builtin_bit_cast(float, s1); }

#ifndef P0_WIDE
#define P0_WIDE 0
#endif
__device__ __forceinline__ void p0_fetch(float (&rg)[32], const float* W, int N, int item, int lane) {
    const int nblk = N / 32, kb = item / nblk, nb = item % nblk, k0 = 64 * kb, n0 = 32 * nb;
#if P0_WIDE
    const float* p = W + (size_t)(k0 + (lane >> 3)) * N + n0 + 4 * (lane & 7);
#pragma unroll
    for (int i = 0; i < 8; ++i) { const f32x4 v = __builtin_nontemporal_load((const f32x4*)(p + (size_t)(8 * i) * N)); rg[4 * i] = v.x; rg[4 * i + 1] = v.y; rg[4 * i + 2] = v.z; rg[4 * i + 3] = v.w; }
#else
    const float* p = W + (size_t)(k0 + (lane >> 5)) * N + n0 + (lane & 31);
#pragma unroll
    for (int i = 0; i < 32; ++i) rg[i] = __builtin_nontemporal_load(p + (size_t)(2 * i) * N);
#endif
}
__device__ __forceinline__ void p0_stash(const float (&rg)[32], LAS float* scr, int lane) {
#if P0_WIDE
#pragma unroll
    for (int i = 0; i < 8; ++i) { LAS float* d = scr + (8 * i + (lane >> 3)) * 33 + 4 * (lane & 7); d[0] = rg[4 * i]; d[1] = rg[4 * i + 1]; d[2] = rg[4 * i + 2]; d[3] = rg[4 * i + 3]; }
#else
#pragma unroll
    for (int i = 0; i < 32; ++i) scr[(2 * i + (lane >> 5)) * 33 + (lane & 31)] = rg[i];
#endif
}
__device__ __forceinline__ void p0_transpose_load(const float* W, int N, LAS float* scr, int item, int lane) {
    float rg[32]; p0_fetch(rg, W, N, item, lane); p0_stash(rg, scr, lane);
}
template <bool TILED>
__device__ __forceinline__ void p0_transpose_store(int K, int N, bf16* WT, LAS float* scr, int item, int lane, int krot) {
    const int nblk = N / 32, kb = item / nblk, nb = item % nblk, k0 = 64 * kb, n0 = 32 * nb;
    const int c = lane & 7;
#pragma unroll
    for (int j = 0; j < 4; ++j) { const int n = (lane >> 3) + 8 * j; const LAS float* s = scr + (8 * c) * 33 + n;
        v4u o; o.x = pk2(s[0 * 33], s[1 * 33]); o.y = pk2(s[2 * 33], s[3 * 33]); o.z = pk2(s[4 * 33], s[5 * 33]); o.w = pk2(s[6 * 33], s[7 * 33]);
#ifdef WT_NT
        __builtin_nontemporal_store(o, (GAS v4u*)(WT + (TILED ? ((size_t)(((k0 + krot) & (K - 1)) >> 6) * N + n0 + n) * 64 : (size_t)(n0 + n) * K + ((k0 + krot) & (K - 1))) + 8 * c)); }
#else
        *(GAS v4u*)(WT + (TILED ? ((size_t)(((k0 + krot) & (K - 1)) >> 6) * N + n0 + n) * 64 : (size_t)(n0 + n) * K + ((k0 + krot) & (K - 1))) + 8 * c) = o; }
#endif
    LDS_WAIT(); asm volatile("" ::: "memory");
}
template <bool TILED>
__device__ __forceinline__ void p0_transpose_item(const float* W, int K, int N, bf16* WT, LAS float* scr, int item, int lane, int krot = 0) {
    p0_transpose_load(W, N, scr, item, lane);
    LDS_WAIT(); asm volatile("" ::: "memory");
    p0_transpose_store<TILED>(K, N, WT, scr, item, lane, krot);
}

__device__ __forceinline__ void p0_mod_phase(Frame& F0, KArgs A0) {
    Frame F = F0; { const int t_ = launder_v((int)threadIdx.x); F.tid = t_; F.lane = t_ & 63; F.wave = __builtin_amdgcn_readfirstlane(t_ >> 6); }
    KArgs A = A0; asm volatile("" : "+s"(A));
    {
        __syncthreads();
        LAS float* cond = (LAS float*)(F.lds + RING_OFF);
        LAS float* red = (LAS float*)(F.lds + RING_OFF + 32768);
        for (int i = F.tid; i < 2 * D; i += NWAVES * 64) { const float v = F_c[i]; cond[i] = siluf_(v); }
        __syncthreads();
        const int c4 = F.lane & 31, half = F.lane >> 5; const bool act = c4 < 24;
        for (int it = blockIdx.x; it < DEPTH * 128; it += F.G) {
            const int l = it >> 7, cg = it & 127;
            const float* W = F_w_ada + (size_t)l * D * (3 * D) + cg * 96 + 4 * (act ? c4 : 0);
            const int kbase = F.wave * 512 + half;
            f32x4 a0 = {0.f, 0.f, 0.f, 0.f}, a1 = {0.f, 0.f, 0.f, 0.f};
            if (act) {
#pragma unroll 8
                for (int i = 0; i < 256; ++i) { const int k = kbase + 2 * i;
                    const f32x4 w = __builtin_nontemporal_load((const f32x4*)(W + (size_t)k * (3 * D)));
                    const float s0 = cond[k], s1 = cond[D + k]; a0 += w * s0; a1 += w * s1; }
            }
#pragma unroll
            for (int j = 0; j < 4; ++j) { a0[j] += __shfl_xor(a0[j], 32); a1[j] += __shfl_xor(a1[j], 32); }
            if (half == 0 && act) {
#pragma unroll
                for (int j = 0; j < 4; ++j) { red[(F.wave * 2 + 0) * 96 + 4 * c4 + j] = a0[j]; red[(F.wave * 2 + 1) * 96 + 4 * c4 + j] = a1[j]; } }
            __syncthreads();
            if (F.tid < 192) { const int b = F.tid / 96, cc = F.tid % 96; float s = 0.f;
#pragma unroll
                for (int w = 0; w < 8; ++w) s += red[(w * 2 + b) * 96 + cc];
                F_MOD[(size_t)(l * 2 + b) * (3 * D) + cg * 96 + cc] = s + F_b_ada[(size_t)l * (3 * D) + cg * 96 + cc]; }
            __syncthreads();
        }
    }
}

__device__ __forceinline__ void p0_convert_phase(Frame& F0, KArgs A0) {
    Frame F = F0; { const int t_ = launder_v((int)threadIdx.x); F.tid = t_; F.lane = t_ & 63; F.wave = __builtin_amdgcn_readfirstlane(t_ >> 6); }
    KArgs A = A0; asm volatile("" : "+s"(A));
    LAS float* scr = (LAS float*)(F.lds + RING_OFF + F.wave * 16384);
    LAS float* shv = scr + 64 * 33;
    const int gw = F.vcu * NWAVES + F.wave;
    constexpr int NB_IN = DIN / 32, N_BIG = DEPTH * NB_IN;
    constexpr int I_OUT = (D / 64) * (D / 32), I_G = 8, N_OUT = DEPTH * I_OUT, N_G = DEPTH * 2 * NBLK * I_G;
    if (gw < N_BIG) {
        const int l = gw / NB_IN, nb = gw % NB_IN, n = F.lane & 31, b = F.lane >> 5;
        const float* W = F_w_in + (size_t)l * D * DIN; bf16* WT = F_WIN + (size_t)l * DIN * D;
        float acc = 0.f;
        for (int kb = 0; kb < D / 64; ++kb) {
            const float s0 = F_MOD[(size_t)(l * 2 + 0) * (3 * D) + 64 * kb + F.lane], s1 = F_MOD[(size_t)(l * 2 + 1) * (3 * D) + 64 * kb + F.lane];
            p0_transpose_load(W, DIN, scr, kb * NB_IN + nb, F.lane);
            shv[F.lane] = s0; shv[64 + F.lane] = s1;
            LDS_WAIT(); asm volatile("" ::: "memory");
#pragma unroll 16
            for (int kk = 0; kk < 64; ++kk) acc = __builtin_fmaf(shv[b * 64 + kk], scr[kk * 33 + n], acc);
            p0_transpose_store<true>(D, DIN, WT, scr, kb * NB_IN + nb, F.lane, 0);
        }
        F_SW[(size_t)(l * 2 + b) * DIN + 32 * nb + n] = acc;
    } else {
        for (int it = gw - N_BIG; it < N_OUT + 2 * N_G; it += F.G * NWAVES - N_BIG) {
            int r = it;
            if (r < N_OUT) { const int l = r / I_OUT; p0_transpose_item<true>(F_w_out + (size_t)l * D * D, D, D, F_WOUT + (size_t)l * D * D, scr, r % I_OUT, F.lane, WL); continue; } r -= N_OUT;
            if (r < N_G) { const int mt = r / I_G; p0_transpose_item<false>(F_lru_wa + (size_t)mt * BW * BW, BW, BW, F_WAT + (size_t)mt * BW * BW, scr, r % I_G, F.lane); continue; } r -= N_G;
            { const int mt = r / I_G; p0_transpose_item<false>(F_lru_wx + (size_t)mt * BW * BW, BW, BW, F_WXT + (size_t)mt * BW * BW, scr, r % I_G, F.lane); }
        }
    }
}

__device__ __forceinline__ void norm0_phase(Frame& F0, KArgs A0, const float* x, int l) {
    Frame F = F0; { const int t_ = launder_v((int)threadIdx.x); F.tid = t_; F.lane = t_ & 63; F.wave = __builtin_amdgcn_readfirstlane(t_ >> 6); }
    KArgs A = A0; asm volatile("" : "+s"(A));
    const int gw = F.vcu * NWAVES + F.wave, NGW = F.G * NWAVES;
    const float* g = F_norm_g + (size_t)l * D;
    for (int m = gw; m < M; m += NGW) {
        const float* modp = F_MOD + (size_t)(l * 2 + (m >> 12)) * (3 * D);
        const GAS f32x4* xr = (const GAS f32x4*)(x + (size_t)m * D) + F.lane;
        f32x4 v[16]; float s = 0.f;
#pragma unroll
        for (int j = 0; j < 16; ++j) { v[j] = xr[64 * j]; s += (v[j].x * v[j].x + v[j].y * v[j].y) + (v[j].z * v[j].z + v[j].w * v[j].w); }
        s = wave_sum(s);
        F_RS[(size_t)m * 64 + F.lane] = (F.lane == 0) ? s : 0.f;
        bf16* hb = F_HB;
#pragma unroll
        for (int j = 0; j < 16; ++j) { const int col = 4 * F.lane + 256 * j;
            const f32x4 g4 = *(const f32x4*)(g + col), sc = *(const f32x4*)(modp + D + col);
            const f32x4 o = v[j] * g4 * (sc + 1.0f);
            v2u w; w.x = pk2(o.x, o.y); w.y = pk2(o.z, o.w); *(GAS v2u*)(hb + a_tiled((size_t)m, col)) = w; }
    }
}

__device__ __forceinline__ void final_norm_phase(Frame& F0, KArgs A0, float* x) {
    Frame F = F0; { const int t_ = launder_v((int)threadIdx.x); F.tid = t_; F.lane = t_ & 63; F.wave = __builtin_amdgcn_readfirstlane(t_ >> 6); }
    KArgs A = A0; asm volatile("" : "+s"(A));
    const int gw = F.vcu * NWAVES + F.wave, NGW = F.G * NWAVES;
    for (int m = gw; m < M; m += NGW) {
        GAS f32x4* xr = (GAS f32x4*)(x + (size_t)m * D) + F.lane;
        f32x4 v[16]; float s = 0.f;
#pragma unroll
        for (int j = 0; j < 16; ++j) { v[j] = xr[64 * j]; s += (v[j].x * v[j].x + v[j].y * v[j].y) + (v[j].z * v[j].z + v[j].w * v[j].w); }
        const float rstd = 1.0f / sqrtf(wave_sum(s) * (1.f / D) + EPS);
#pragma unroll
        for (int j = 0; j < 16; ++j) { const f32x4 g4 = *(const f32x4*)(F_final_g + 4 * F.lane + 256 * j); xr[64 * j] = (v[j] * rstd) * g4; }
    }
}

typedef float f32x16 __attribute__((ext_vector_type(16)));
constexpr int X16P = 136;
constexpr int LRU_X32 = 0, LRU_X16 = TC * BW * 4, LRU_RES = LRU_X16 + TC * X16P * 2, LRU_END = LRU_RES + 2 * TC * BW * 4;
static_assert(LRU_END <= RING_BYTES && (LRU_X16 % 16) == 0 && (LRU_RES % 16) == 0, "LRU LDS map");
constexpr float LOG2E = 1.4426950408889634f;

template <int E>
__device__ __forceinline__ void lru_tile(const f32x16& accR, const f32x16& accI, const LAS float* xrow, LAS unsigned* rrow, int h, float bR, float bI, float c1, float& Hc, float& Pc) {
    float a[16], bb[16];
    typedef float f2 __attribute__((ext_vector_type(2)));
    const float nbR = -LOG2E * bR, nbI = -LOG2E * bI;
#pragma unroll
    for (int rp = 0; rp < 8; ++rp) {
        const int r0 = 2 * rp, r1 = r0 + 1;
        const f2 xc = {xrow[((r0 & 3) + 8 * (r0 >> 2)) * BW], xrow[((r1 & 3) + 8 * (r1 >> 2)) * BW]};
        const f2 er = (f2){accR[r0], accR[r1]} * (-LOG2E) + nbR, ei = (f2){accI[r0], accI[r1]} * (-LOG2E) + nbI;
        const f2 dr = (f2){__builtin_amdgcn_exp2f(er.x), __builtin_amdgcn_exp2f(er.y)} + 1.0f, di = (f2){__builtin_amdgcn_exp2f(ei.x), __builtin_amdgcn_exp2f(ei.y)} + 1.0f;
        const f2 r = {__builtin_amdgcn_rcpf(dr.x), __builtin_amdgcn_rcpf(dr.y)}, ig = {__builtin_amdgcn_rcpf(di.x), __builtin_amdgcn_rcpf(di.y)};
        const f2 ca = r * c1;
        const f2 av = {__builtin_amdgcn_exp2f(ca.x), __builtin_amdgcn_exp2f(ca.y)};
        const f2 om = 1.0f - av * av;
        const f2 sq = {__builtin_amdgcn_sqrtf(om.x), __builtin_amdgcn_sqrtf(om.y)};
        const f2 bv = sq * (ig * xc);
        a[r0] = av.x; a[r1] = av.y; bb[r0] = bv.x; bb[r1] = bv.y;
    }
    float lcl[16], p[16], As[4], Bs[4], Ao[4], Bo[4];
#pragma unroll
    for (int g = 0; g < 4; ++g) {
        if (E == 0) {
            lcl[4 * g] = bb[4 * g]; p[4 * g] = a[4 * g];
#pragma unroll
            for (int i = 1; i < 4; ++i) { lcl[4 * g + i] = __builtin_fmaf(a[4 * g + i], lcl[4 * g + i - 1], bb[4 * g + i]); p[4 * g + i] = a[4 * g + i] * p[4 * g + i - 1]; }
            As[g] = p[4 * g + 3]; Bs[g] = lcl[4 * g + 3];
        } else {
            lcl[4 * g + 3] = bb[4 * g + 3]; p[4 * g + 3] = a[4 * g + 3];
#pragma unroll
            for (int i = 2; i >= 0; --i) { lcl[4 * g + i] = __builtin_fmaf(a[4 * g + i], lcl[4 * g + i + 1], bb[4 * g + i]); p[4 * g + i] = a[4 * g + i] * p[4 * g + i + 1]; }
            As[g] = p[4 * g]; Bs[g] = lcl[4 * g];
        }
        { const auto ta = __builtin_amdgcn_permlane32_swap(__builtin_bit_cast(unsigned, As[g]), __builtin_bit_cast(unsigned, As[g]), false, false);
          const auto tb = __builtin_amdgcn_permlane32_swap(__builtin_bit_cast(unsigned, Bs[g]), __builtin_bit_cast(unsigned, Bs[g]), false, false);
          const unsigned a0_ = ta[0], a1_ = ta[1], b0_ = tb[0], b1_ = tb[1];
          As[g] = __builtin_bit_cast(float, a0_); Ao[g] = __builtin_bit_cast(float, a1_); Bs[g] = __builtin_bit_cast(float, b0_); Bo[g] = __builtin_bit_cast(float, b1_); }
    }
    float cinH[4], cinP[4];
#pragma unroll
    for (int gg = 0; gg < 4; ++gg) {
        const int g = (E == 0) ? gg : (3 - gg);
        const float A0 = As[g], B0 = Bs[g];
        const float A1 = Ao[g], B1 = Bo[g];
        float H0, P0, H1, P1;
        if (E == 0) { H0 = Hc; P0 = Pc; Hc = __builtin_fmaf(A0, Hc, B0); Pc *= A0; H1 = Hc; P1 = Pc; Hc = __builtin_fmaf(A1, Hc, B1); Pc *= A1; }
        else        { H1 = Hc; P1 = Pc; Hc = __builtin_fmaf(A1, Hc, B1); Pc *= A1; H0 = Hc; P0 = Pc; Hc = __builtin_fmaf(A0, Hc, B0); Pc *= A0; }
        cinH[g] = h ? H1 : H0; cinP[g] = h ? P1 : P0;
    }
#pragma unroll
    for (int reg = 0; reg < 16; ++reg) {
        const float lh = __builtin_fmaf(p[reg], cinH[reg >> 2], lcl[reg]), pv = p[reg] * cinP[reg >> 2];
        rrow[((reg & 3) + 8 * (reg >> 2)) * BW] = pk2(lh, pv);
    }
}

__device__ __forceinline__ void lru_local_phase(Frame& F0, KArgs A0, int l) {
    Frame F = F0; { const int t_ = launder_v((int)threadIdx.x); F.tid = t_; F.lane = t_ & 63; F.wave = __builtin_amdgcn_readfirstlane(t_ >> 6); }
    KArgs A = A0; asm volatile("" : "+s"(A));
    LAS float* X32 = (LAS float*)(F.lds + RING_OFF + LRU_X32);
    LAS unsigned char* X16 = F.lds + RING_OFF + LRU_X16;
    LAS unsigned* RES = (LAS unsigned*)(F.lds + RING_OFF + LRU_RES);
    const int tid = F.tid, lane = F.lane;
    const int e = F.wave & 1, cb = F.wave >> 1, jl = lane & 31, h = lane >> 5;
    const int ch4 = tid & 31, tq = tid >> 5;
    bf16x8 WR[8], WI[8]; float bR = 0.f, bI = 0.f, c1 = 0.f; int last_n = -1;
#define LRU_LOAD_ROWS(dst, uu) do { const int n_ = (uu) & (NBLK - 1), pc_ = (uu) >> 4, b_ = pc_ / NCH, t0_ = (pc_ % NCH) * TC; \
        const bf16* xa_ = F_PB + p_idx((size_t)(b_ * SEQ), OFF_XA + n_ * BW) + 4 * ch4; \
        _Pragma("unroll") for (int i_ = 0; i_ < 7; ++i_) { const int t_ = t0_ + 4 * tq - 2 + i_; const int tc_ = min(max(t_, 0), SEQ - 1); \
            v2u w_ = *(const v2u*)(xa_ + (size_t)tc_ * 128); if (t_ != tc_) { w_.x = 0u; w_.y = 0u; } (dst)[i_] = w_; } } while (0)
    v2u rwn[7];
    if (F.cid < BATCH * NCH * NBLK) LRU_LOAD_ROWS(rwn, F.cid);
    for (int u = F.cid; u < BATCH * NCH * NBLK; u += F.G) {
        const int n = u & (NBLK - 1), pc = u >> 4, b = pc / NCH, cidx = pc % NCH, t0 = cidx * TC;
        if (n != last_n) {
            last_n = n;
            const bf16* wr = F_WAT + ((size_t)((l * 2 + e) * NBLK + n) * BW + 32 * cb + jl) * BW + 8 * h;
            const bf16* wi = F_WXT + ((size_t)((l * 2 + e) * NBLK + n) * BW + 32 * cb + jl) * BW + 8 * h;
#pragma unroll
            for (int s = 0; s < 8; ++s) { WR[s] = *(const bf16x8*)(wr + 16 * s); WI[s] = *(const bf16x8*)(wi + 16 * s); }
            const int ch = n * BW + 32 * cb + jl;
            bR = F_lru_ba[(size_t)(l * 2 + e) * WL + ch]; bI = F_lru_bx[(size_t)(l * 2 + e) * WL + ch];
            c1 = -C_RG * LOG2E * log1pf(expf(-F_lru_lambda[(size_t)(l * 2 + e) * WL + ch]));
        }
        {
            f32x4 rw[7];
#pragma unroll
            for (int i = 0; i < 7; ++i) rw[i] = (f32x4){bflo(rwn[i].x), bfhi(rwn[i].x), bflo(rwn[i].y), bfhi(rwn[i].y)};
            const float* cwp = F_conv_w + (size_t)l * 4 * WL + n * BW + 4 * ch4;
            const f32x4 w0 = *(const f32x4*)(cwp), w1 = *(const f32x4*)(cwp + WL), w2 = *(const f32x4*)(cwp + 2 * WL), w3 = *(const f32x4*)(cwp + 3 * WL);
            const f32x4 cbv = *(const f32x4*)(F_conv_b + (size_t)l * WL + n * BW + 4 * ch4);
#pragma unroll
            for (int i = 0; i < 4; ++i) { const f32x4 xc = cbv + w0 * rw[i] + w1 * rw[i + 1] + w2 * rw[i + 2] + w3 * rw[i + 3];
                const int t = 4 * tq + i;
                *(LAS f32x4*)(X32 + t * BW + 4 * ch4) = xc;
                v2u w; w.x = pk2(xc.x, xc.y); w.y = pk2(xc.z, xc.w); *(LAS v2u*)(X16 + (t * X16P + 4 * ch4) * 2) = w; }
        }
        if (u + F.G < BATCH * NCH * NBLK) LRU_LOAD_ROWS(rwn, u + F.G);
        __syncthreads();
        {
            float Hc = 0.f, Pc = 1.f;
#pragma unroll
            for (int tt = 0; tt < TC / 32; ++tt) {
                const int tile = e ? (TC / 32 - 1 - tt) : tt;
                bf16x8 Af[8];
                const LAS unsigned char* ap = X16 + ((32 * tile + jl) * X16P + 8 * h) * 2;
#pragma unroll
                for (int s = 0; s < 8; ++s) Af[s] = *(const LAS bf16x8*)(ap + 32 * s);
                f32x16 accR, accI;
#pragma unroll
                for (int i = 0; i < 16; ++i) { accR[i] = 0.f; accI[i] = 0.f; }
#pragma unroll
                for (int s = 0; s < 8; ++s) { accR = __builtin_amdgcn_mfma_f32_32x32x16_bf16(Af[s], WR[s], accR, 0, 0, 0); accI = __builtin_amdgcn_mfma_f32_32x32x16_bf16(Af[s], WI[s], accI, 0, 0, 0); }
                const LAS float* xrow = X32 + (32 * tile + 4 * h) * BW + 32 * cb + jl;
                LAS unsigned* rrow = RES + (e * TC + 32 * tile + 4 * h) * BW + 32 * cb + jl;
                if (e == 0) lru_tile<0>(accR, accI, xrow, rrow, h, bR, bI, c1, Hc, Pc); else lru_tile<1>(accR, accI, xrow, rrow, h, bR, bI, c1, Hc, Pc);
            }
            if (h == 0) { gu64* sp = (gu64*)(F_SUM + ((size_t)((b * NCH + cidx) * 2 + e) * WL + n * BW + 32 * cb + jl) * 2);
                __hip_atomic_store(sp, ((unsigned long long)__builtin_bit_cast(unsigned, Hc) << 32) | __builtin_bit_cast(unsigned, Pc), RLX_AGENT); }
        }
        __syncthreads();
        {
#pragma unroll
            for (int i = 0; i < 4; ++i) { const int t = 4 * tq + i;
                const v4u f = *(const LAS v4u*)(RES + t * BW + 4 * ch4), k = *(const LAS v4u*)(RES + (TC + t) * BW + 4 * ch4);
                v2u lh, pf, pb;
                lh.x = pk2(bflo(f.x) + bflo(k.x), bflo(f.y) + bflo(k.y)); lh.y = pk2(bflo(f.z) + bflo(k.z), bflo(f.w) + bflo(k.w));
                pf.x = (f.x >> 16) | (f.y & 0xffff0000u); pf.y = (f.z >> 16) | (f.w & 0xffff0000u);
                pb.x = (k.x >> 16) | (k.y & 0xffff0000u); pb.y = (k.z >> 16) | (k.w & 0xffff0000u);
                const size_t o = ((size_t)((b * NCH + cidx) * NBLK + n) * TC + t) * BW + 4 * ch4;
                *(v2u*)(F_LH + o) = lh; *(v2u*)(F_PF + o) = pf; *(v2u*)(F_PBK + o) = pb; }
        }
    }
#undef LRU_LOAD_ROWS
    {
        const int n = F.cid & (NBLK - 1);
        LAS unsigned* flg = (LAS unsigned*)(F.lds + RING_OFF + LRU_END);
        asm volatile("s_waitcnt vmcnt(0)" ::: "memory");
        __syncthreads();
        if (tid == 0) { const unsigned old = __hip_atomic_fetch_add((unsigned*)(F_ctl + CW_CARRY + 16 * (16 * l + n)), 1u, __ATOMIC_RELAXED, __HIP_MEMORY_SCOPE_AGENT);
            if (old == (unsigned)(F.G / NBLK) - 1u) { __builtin_amdgcn_fence(__ATOMIC_ACQUIRE, "agent"); asm volatile("s_waitcnt vmcnt(0)" ::: "memory"); }
            flg[0] = (old == (unsigned)(F.G / NBLK) - 1u) ? 1u : 0u; }
        __syncthreads();
        if (flg[0] != 0u) {
            const int bb = tid >> 8, ee = (tid >> 7) & 1, ch = n * BW + (tid & 127);
            float cin = 0.f;
#ifndef CHB
#define CHB 32
#endif
#pragma unroll 1
            for (int s0 = 0; s0 < NCH; s0 += CHB) {
                unsigned long long sw_[CHB];
#pragma unroll
                for (int s = 0; s < CHB; ++s) { const int ci = ee ? (NCH - 1 - (s0 + s)) : (s0 + s);
                    sw_[s] = __hip_atomic_load((gu64*)(F_SUM + ((size_t)((bb * NCH + ci) * 2 + ee) * WL + ch) * 2), RLX_AGENT); }
#pragma unroll
                for (int s = 0; s < CHB; ++s) { const int ci = ee ? (NCH - 1 - (s0 + s)) : (s0 + s);
                    const size_t o = (size_t)((bb * NCH + ci) * 2 + ee) * WL + ch;
                    __hip_atomic_store((gu32*)(F_CAR + o), __builtin_bit_cast(unsigned, cin), RLX_AGENT);
                    cin = __builtin_fmaf(__builtin_bit_cast(float, (unsigned)sw_[s]), cin, __builtin_bit_cast(float, (unsigned)(sw_[s] >> 32))); }
            }
            asm volatile("s_waitcnt vmcnt(0)" ::: "memory");
            __syncthreads();
            if (tid == 0) __hip_atomic_store((gu32*)(F_ctl + CW_CREADY + 16 * (16 * l + n)), 1u, RLX_AGENT);
        }
        __syncthreads();
    }
}

typedef short s16x4 __attribute__((ext_vector_type(4)));
typedef LAS s16x4 lds_s16x4;
constexpr int ATT_SLOT = 32768;
constexpr int ATT_NSLOT = 4;
constexpr int ATT_BTAB = ATT_NSLOT * ATT_SLOT;
static_assert(ATT_BTAB + 2048 <= PHASE_LDS, "attention LDS map");

template <int DLT>
__device__ __forceinline__ void attn_pair_task(KArgs A, int l, int b, int h, int j4, int wave, int lane, LAS unsigned char* ring, const LAS float* btab) {
    constexpr int NU = 8 + DLT;
    const int q = lane & 15, g = lane >> 4, pr = wave >> 2, qt = wave & 3;
    const float SCL2 = 0.08838834764831845f * LOG2E;
    const int rA = 4 * j4 + 2 * pr, rB = rA + 1;
    const int kr0 = min(max(4 * j4 - 4, 0), ROWS - KR);
    const int rs = min(max(rA - 4, 0), ROWS - KR);
    const int PRE = rs - kr0, NS = min(max(4 * j4 - 2, 0), ROWS - KR) + NU - kr0;
    const int c0 = 16 * qt, kb = min(max(c0 - 8, 0), 32), xb = (kb >> 3) & 1;
    const int c = c0 + q, cs = min(max(c - 8, 0), GW - KC);
    const char* ksrc = (const char*)(F_PB + p_idx((size_t)(b * SEQ + kr0 * GW), OFF_K + h * HD)) + 2048 * wave;
    const char* vsrc = (const char*)(F_PB + p_idx((size_t)(b * SEQ + kr0 * GW), OFF_V + h * HD)) + 2048 * wave;
    LAS unsigned char* dstw = ring + 2048 * wave;
    const unsigned lofs0 = (unsigned)(g * 128) * 2u + 16u * (unsigned)(q ^ ((g << 2) | ((2 * wave) & 3)));
    const unsigned lofs1 = (unsigned)(g * 128) * 2u + 16u * (unsigned)(q ^ ((g << 2) | ((2 * wave + 1) & 3)));
#define ROW_DMA(s_) do { const int s2_ = (s_), r2_ = min(s2_, NS - 1);     \
        const char* kp_ = ksrc + (size_t)r2_ * (GW * 256); const char* vp_ = vsrc + (size_t)r2_ * (GW * 256); LAS unsigned char* d_ = dstw + (s2_ & (ATT_NSLOT - 1)) * ATT_SLOT; \
        asm volatile("" : "+s"(kp_), "+s"(vp_));                     \
        __builtin_amdgcn_global_load_lds((const unsigned*)(kp_ + lofs0), (LAS unsigned*)(d_), 16, 0, 0); \
        __builtin_amdgcn_global_load_lds((const unsigned*)(kp_ + 1024 + lofs1), (LAS unsigned*)(d_ + 1024), 16, 0, 0); \
        __builtin_amdgcn_global_load_lds((const unsigned*)(vp_ + lofs0), (LAS unsigned*)(d_ + 16384), 16, 0, 0); \
        __builtin_amdgcn_global_load_lds((const unsigned*)(vp_ + 1024 + lofs1), (LAS unsigned*)(d_ + 16384 + 1024), 16, 0, 0); } while (0)
#define ROW_SYNC(s_) do { const int s1_ = (s_); asm volatile("s_waitcnt vmcnt(8)" ::: "memory"); __builtin_amdgcn_s_barrier(); asm volatile("" ::: "memory"); ROW_DMA(s1_ + 3); } while (0)
    bf16x8 QA[4], QB[4];
    { const bf16* qp = F_PB + p_idx((size_t)(b * SEQ + rA * GW + c), OFF_Q + h * HD) + 8 * g;
#pragma unroll
      for (int s = 0; s < 4; ++s) { QA[s] = *(const bf16x8*)(qp + 32 * s); QB[s] = *(const bf16x8*)(qp + (size_t)GW * 128 + 32 * s); } }
    asm volatile("s_waitcnt vmcnt(0)" : "+v"(QA[0]), "+v"(QA[1]), "+v"(QA[2]), "+v"(QA[3]), "+v"(QB[0]), "+v"(QB[1]), "+v"(QB[2]), "+v"(QB[3]) :: "memory");
    ROW_DMA(0); ROW_DMA(1); ROW_DMA(2);
    const unsigned ringa = (unsigned)(size_t)ring;
    const unsigned kf0 = ringa + 256u * (unsigned)(kb + 8 * (q >> 2) + (q & 3)) + 16u * (unsigned)(g ^ (2 * xb) ^ ((2 * (q >> 2)) & 3));
    const unsigned kf1 = ringa + 256u * (unsigned)(kb + 8 * (q >> 2) + 4 + (q & 3)) + 16u * (unsigned)(g ^ (2 * xb) ^ ((2 * (q >> 2) + 1) & 3));
    const unsigned kx = 64u * (unsigned)(q & 3);
    const unsigned tqq = (unsigned)(q >> 2), tp = (unsigned)(q & 3);
    const unsigned tr0 = ringa + 16384u + 256u * (unsigned)(kb + 8 * g) + 256u * tqq + 32u * ((tqq << 1) | (unsigned)((g & 1) ^ xb)) + 16u * (tp >> 1) + 8u * (tp & 1);
    const unsigned tr1 = ringa + 16384u + 256u * (unsigned)(kb + 8 * g + 4) + 256u * tqq + 32u * ((tqq << 1) | (unsigned)((g & 1) ^ xb)) + 16u * ((tp >> 1) ^ 1u) + 8u * (tp & 1);
    const int dv = kb + 8 * g - cs;
    const LAS float* btA = btab + 8 + (rs - rA + (KR - 1)) * (2 * KC - 1) + (kb + 8 * g - c + (KC - 1));
    const LAS float* btB = btA - (2 * KC - 1);
    float mA = -INFINITY, mB = -INFINITY, lA = 0.f, lB = 0.f;
    f32x4 oA[8], oB[8];
#pragma unroll
    for (int c4 = 0; c4 < 8; ++c4) { oA[c4] = (f32x4){0.f, 0.f, 0.f, 0.f}; oB[c4] = (f32x4){0.f, 0.f, 0.f, 0.f}; }
    for (int s = 0; s < PRE; ++s) ROW_SYNC(s);
#pragma unroll
    for (int u = 0; u < NU; ++u) {
        ROW_SYNC(PRE + u);
        unsigned sb = (unsigned)((PRE + u) & (ATT_NSLOT - 1)) * (unsigned)ATT_SLOT;
        asm volatile("" : "+s"(sb));
        f32x4 a0 = {0.f, 0.f, 0.f, 0.f}, a1 = {0.f, 0.f, 0.f, 0.f}, b0 = {0.f, 0.f, 0.f, 0.f}, b1 = {0.f, 0.f, 0.f, 0.f};
#pragma unroll
        for (int s = 0; s < 4; ++s) {
            const bf16x8 k0 = *(const LAS bf16x8*)(size_t)(kf0 + sb + ((64u * s) ^ kx)), k1 = *(const LAS bf16x8*)(size_t)(kf1 + sb + ((64u * s) ^ kx));
            if (u < 8) { a0 = __builtin_amdgcn_mfma_f32_16x16x32_bf16(k0, QA[s], a0, 0, 0, 0); a1 = __builtin_amdgcn_mfma_f32_16x16x32_bf16(k1, QA[s], a1, 0, 0, 0); }
            if (u >= DLT) { b0 = __builtin_amdgcn_mfma_f32_16x16x32_bf16(k0, QB[s], b0, 0, 0, 0); b1 = __builtin_amdgcn_mfma_f32_16x16x32_bf16(k1, QB[s], b1, 0, 0, 0); } }
        asm volatile("s_waitcnt lgkmcnt(0)" ::: "memory");
        bf16x8 PA, PB_;
        if (u < 8) {
            float v[8], rm = -INFINITY;
#pragma unroll
            for (int j = 0; j < 8; ++j) { const float t_ = __builtin_fmaf(j < 4 ? a0[j & 3] : a1[j & 3], SCL2, btA[(2 * KC - 1) * u + j]); v[j] = ((unsigned)(dv + j) < (unsigned)KC) ? t_ : -INFINITY; rm = fmaxf(rm, v[j]); }
            rm = xor32_max(xor16_max(rm));
            const float mn = fmaxf(mA, rm), al = __builtin_amdgcn_exp2f(mA - mn); mA = mn;
            float ps = 0.f;
#pragma unroll
            for (int j = 0; j < 8; ++j) { v[j] = __builtin_amdgcn_exp2f(v[j] - mn); ps += v[j]; }
            lA = __builtin_fmaf(lA, al, ps); asm volatile("" : "+v"(lA));
#pragma unroll
            for (int c4 = 0; c4 < 8; ++c4) oA[c4] *= al;
            v4u w; w.x = pk2(v[0], v[1]); w.y = pk2(v[2], v[3]); w.z = pk2(v[4], v[5]); w.w = pk2(v[6], v[7]); PA = __builtin_bit_cast(bf16x8, w);
        }
        if (u >= DLT) {
            float v[8], rm = -INFINITY;
#pragma unroll
            for (int j = 0; j < 8; ++j) { const float t_ = __builtin_fmaf(j < 4 ? b0[j & 3] : b1[j & 3], SCL2, btB[(2 * KC - 1) * u + j]); v[j] = ((unsigned)(dv + j) < (unsigned)KC) ? t_ : -INFINITY; rm = fmaxf(rm, v[j]); }
            rm = xor32_max(xor16_max(rm));
            const float mn = fmaxf(mB, rm), al = __builtin_amdgcn_exp2f(mB - mn); mB = mn;
            float ps = 0.f;
#pragma unroll
            for (int j = 0; j < 8; ++j) { v[j] = __builtin_amdgcn_exp2f(v[j] - mn); ps += v[j]; }
            lB = __builtin_fmaf(lB, al, ps); asm volatile("" : "+v"(lB));
#pragma unroll
            for (int c4 = 0; c4 < 8; ++c4) oB[c4] *= al;
            v4u w; w.x = pk2(v[0], v[1]); w.y = pk2(v[2], v[3]); w.z = pk2(v[4], v[5]); w.w = pk2(v[6], v[7]); PB_ = __builtin_bit_cast(bf16x8, w);
        }
        asm volatile("s_waitcnt lgkmcnt(0)" ::: "memory");
        {
            const unsigned t0 = tr0 + sb, t1 = tr1 + sb;
            s16x4 lo[8], hi[8];
#define TR8(dst, base) asm volatile("ds_read_b64_tr_b16 %0, %8\n\tds_read_b64_tr_b16 %1, %9\n\tds_read_b64_tr_b16 %2, %10\n\tds_read_b64_tr_b16 %3, %11\n\t" \
                "ds_read_b64_tr_b16 %4, %12\n\tds_read_b64_tr_b16 %5, %13\n\tds_read_b64_tr_b16 %6, %14\n\tds_read_b64_tr_b16 %7, %15\n\ts_waitcnt lgkmcnt(0)" \
                : "=&v"((dst)[0]), "=&v"((dst)[1]), "=&v"((dst)[2]), "=&v"((dst)[3]), "=&v"((dst)[4]), "=&v"((dst)[5]), "=&v"((dst)[6]), "=&v"((dst)[7]) \
                : "v"((base) ^ 0u), "v"((base) ^ 32u), "v"((base) ^ 64u), "v"((base) ^ 96u), "v"((base) ^ 128u), "v"((base) ^ 160u), "v"((base) ^ 192u), "v"((base) ^ 224u) : "memory")
            TR8(lo, t0); TR8(hi, t1);
#undef TR8
#pragma unroll
            for (int c4 = 0; c4 < 8; ++c4) { const bf16x8 vf = __builtin_shufflevector(lo[c4], hi[c4], 0, 1, 2, 3, 4, 5, 6, 7);
                if (u < 8) oA[c4] = __builtin_amdgcn_mfma_f32_16x16x32_bf16(vf, PA, oA[c4], 0, 0, 0);
                if (u >= DLT) oB[c4] = __builtin_amdgcn_mfma_f32_16x16x32_bf16(vf, PB_, oB[c4], 0, 0, 0); }
        }
        asm volatile("s_waitcnt lgkmcnt(0)" ::: "memory");
    }
    for (int s = PRE + NU; s < NS; ++s) ROW_SYNC(s);
#undef ROW_DMA
#undef ROW_SYNC
    lA = xor32_sum(xor16_sum(lA)); lB = xor32_sum(xor16_sum(lB));
    const float invA = 1.0f / lA, invB = 1.0f / lB;
    int ce = c; asm volatile("" : "+v"(ce));
    const int gl = launder_v(lane) >> 4, dB = 8 * (gl >> 1) + 16 * (gl & 1);
    f32x4 gn[4][2];
    { const float* gnp = F_gn_att + (size_t)l * WA + h * HD + dB;
#pragma unroll
      for (int m = 0; m < 4; ++m) { gn[m][0] = *(const f32x4*)(gnp + 32 * m); gn[m][1] = *(const f32x4*)(gnp + 32 * m + 4); } }
#pragma unroll
    for (int w2 = 0; w2 < 2; ++w2) {
        f32x4 (&o)[8] = w2 ? oB : oA; const float inv = w2 ? invB : invA;
        const size_t tok = (size_t)(b * SEQ + (w2 ? rB : rA) * GW + ce);
        const bf16* gbp = F_PB + p_idx(tok, OFF_GB + h * HD) + dB;
        v4u gw_[4];
#pragma unroll
        for (int m = 0; m < 4; ++m) gw_[m] = *(const v4u*)(gbp + 32 * m);
        float ss = 0.f;
#pragma unroll
        for (int c4 = 0; c4 < 8; ++c4) { o[c4] *= inv; ss += (o[c4].x * o[c4].x + o[c4].y * o[c4].y) + (o[c4].z * o[c4].z + o[c4].w * o[c4].w); }
#pragma unroll
        for (int m = 0; m < 4; ++m)
#pragma unroll
            for (int r = 0; r < 4; ++r) { const float e0_ = o[2 * m][r], e1_ = o[2 * m + 1][r];
                const auto sw_ = __builtin_amdgcn_permlane16_swap(__builtin_bit_cast(unsigned, e0_), __builtin_bit_cast(unsigned, e1_), false, false);
                const unsigned s0_ = sw_[0], s1_ = sw_[1]; o[2 * m][r] = __builtin_bit_cast(float, s0_); o[2 * m + 1][r] = __builtin_bit_cast(float, s1_); }
#pragma unroll
        for (int m = 0; m < 4; ++m) { const f32x4 v0 = o[2 * m] * gn[m][0], v1 = o[2 * m + 1] * gn[m][1];
            v4u w; w.x = pk2(v0.x * siluf_(bflo(gw_[m].x)), v0.y * siluf_(bfhi(gw_[m].x))); w.y = pk2(v0.z * siluf_(bflo(gw_[m].y)), v0.w * siluf_(bfhi(gw_[m].y)));
            w.z = pk2(v1.x * siluf_(bflo(gw_[m].z)), v1.y * siluf_(bfhi(gw_[m].z))); w.w = pk2(v1.z * siluf_(bflo(gw_[m].w)), v1.w * siluf_(bfhi(gw_[m].w)));
            *(v4u*)(F_YC + a_tiled(tok, h * HD + 32 * m + dB)) = w; }
        ss = xor32_sum(xor16_sum(ss));
        if (gl == 0) F_SSQ[tok * NH + h] = ss;
    }
}

__device__ __forceinline__ void attn_phase(Frame& F0, KArgs A0, int l) {
    Frame F = F0; { const int t_ = launder_v((int)threadIdx.x); F.tid = t_; F.lane = t_ & 63; F.wave = __builtin_amdgcn_readfirstlane(t_ >> 6); }
    KArgs A = A0; asm volatile("" : "+s"(A));
    const int lane = F.lane;
    LAS unsigned char* ring = F.lds + RING_OFF;
    LAS float* btab = (LAS float*)(F.lds + RING_OFF + ATT_BTAB);
    const int xg = F.cid & 7, j4 = (F.cid >> 3) & 15;
    for (int it = 0; it < (BATCH * NH) / 16; ++it) {
        const int pair = xg + 8 * (2 * it + (F.cid >> 7)), b = pair >> 4, h = pair & 15;
        asm volatile("s_waitcnt vmcnt(0) lgkmcnt(0)" ::: "memory");
        __syncthreads();
        {
            const float* rpb_ = F_rpb + (size_t)(l * NH + h) * ((2 * KR - 1) * (2 * KC - 1));
            if (F.tid < 512) { const int idx = F.tid - 8; btab[F.tid] = (idx >= 0 && idx < (2 * KR - 1) * (2 * KC - 1)) ? rpb_[idx] * LOG2E : 0.f; }
        }
        __syncthreads();
        const int r0 = 4 * j4;
        const int dlt = min(max(r0 - 3, 0), ROWS - KR) - min(max(r0 - 4, 0), ROWS - KR);
        if (dlt == 0) attn_pair_task<0>(A, l, b, h, j4, F.wave, lane, ring, btab);
        else          attn_pair_task<1>(A, l, b, h, j4, F.wave, lane, ring, btab);
    }
    asm volatile("s_waitcnt vmcnt(0) lgkmcnt(0)" ::: "memory");
}

__device__ __forceinline__ void lru_fix_phase(Frame& F0, KArgs A0, int l) {
    Frame F = F0; { const int t_ = launder_v((int)threadIdx.x); F.tid = t_; F.lane = t_ & 63; F.wave = __builtin_amdgcn_readfirstlane(t_ >> 6); }
    KArgs A = A0; asm volatile("" : "+s"(A));
    const int tid = F.tid, n = F.cid & (NBLK - 1), ch4 = tid & 31, tq = tid >> 5;
    if (tid == 0) {
        gu32* flag = (gu32*)(F_ctl + CW_CREADY + 16 * (16 * l + n)); unsigned sp = 0;
        while (__hip_atomic_load(flag, RLX_AGENT) == 0u) { __builtin_amdgcn_s_sleep(2);
            if ((++sp & 1023u) == 0u && sp > (1u << 22)) { __hip_atomic_store((gu32*)(F_ctl + CW_TMO), 1u, RLX_AGENT); break; } }
        __builtin_amdgcn_fence(__ATOMIC_ACQUIRE, "agent");
        asm volatile("s_waitcnt vmcnt(0)" ::: "memory");
    }
    __syncthreads();
    const float* gl = F_gn_lru + (size_t)l * WL + n * BW + 4 * ch4;
    const f32x4 g4 = *(const f32x4*)gl;
    for (int u = F.cid; u < BATCH * NCH * NBLK; u += F.G) {
        const int pc = u >> 4, b = pc / NCH, cidx = pc % NCH, t0 = cidx * TC;
        const size_t co = (size_t)((b * NCH + cidx) * 2) * WL + n * BW + 4 * ch4;
        const unsigned long long c0 = __hip_atomic_load((gu64*)(F_CAR + co), RLX_AGENT), c1 = __hip_atomic_load((gu64*)(F_CAR + co + 2), RLX_AGENT);
        const unsigned long long d0 = __hip_atomic_load((gu64*)(F_CAR + co + WL), RLX_AGENT), d1 = __hip_atomic_load((gu64*)(F_CAR + co + WL + 2), RLX_AGENT);
        const f32x4 cf = {__builtin_bit_cast(float, (unsigned)c0), __builtin_bit_cast(float, (unsigned)(c0 >> 32)), __builtin_bit_cast(float, (unsigned)c1), __builtin_bit_cast(float, (unsigned)(c1 >> 32))};
        const f32x4 cb = {__builtin_bit_cast(float, (unsigned)d0), __builtin_bit_cast(float, (unsigned)(d0 >> 32)), __builtin_bit_cast(float, (unsigned)d1), __builtin_bit_cast(float, (unsigned)(d1 >> 32))};
        v2u lhw[4], pfw[4], pbw[4], gg[4];
#pragma unroll
        for (int i = 0; i < 4; ++i) { const size_t tok = (size_t)(b * SEQ + t0 + 4 * tq + i), o = ((size_t)((b * NCH + cidx) * NBLK + n) * TC + 4 * tq + i) * BW + 4 * ch4;
            lhw[i] = *(const v2u*)(F_LH + o); pfw[i] = *(const v2u*)(F_PF + o); pbw[i] = *(const v2u*)(F_PBK + o); gg[i] = *(const v2u*)(F_PB + p_idx(tok, OFF_GA + n * BW) + 4 * ch4); }
        float q[4];
#pragma unroll
        for (int i = 0; i < 4; ++i) { const size_t tok = (size_t)(b * SEQ + t0 + 4 * tq + i);
            const f32x4 lh = {bflo(lhw[i].x), bfhi(lhw[i].x), bflo(lhw[i].y), bfhi(lhw[i].y)}, pf = {bflo(pfw[i].x), bfhi(pfw[i].x), bflo(pfw[i].y), bfhi(pfw[i].y)}, pb = {bflo(pbw[i].x), bfhi(pbw[i].x), bflo(pbw[i].y), bfhi(pbw[i].y)};
            const f32x4 ya = lh + pf * cf + pb * cb;
            q[i] = (ya.x * ya.x + ya.y * ya.y) + (ya.z * ya.z + ya.w * ya.w);
            v2u w; w.x = pk2(ya.x * g4.x * siluf_(bflo(gg[i].x)), ya.y * g4.y * siluf_(bfhi(gg[i].x))); w.y = pk2(ya.z * g4.z * siluf_(bflo(gg[i].y)), ya.w * g4.w * siluf_(bfhi(gg[i].y)));
            *(v2u*)(F_YC + a_tiled(tok, WL + n * BW + 4 * ch4)) = w; }
#pragma unroll
        for (int i = 0; i < 4; ++i) {
#pragma unroll
            for (int o = 1; o < 32; o <<= 1) q[i] += __shfl_xor(q[i], o);
            if (ch4 == 0) F_SSA[(size_t)(b * SEQ + t0 + 4 * tq + i) * NBLK + n] = q[i]; }
    }
}

#ifndef REP_P0
#define REP_P0 1
#endif
#ifndef REP_P0A
#define REP_P0A 1
#endif
#ifndef REP_NORM
#define REP_NORM 1
#endif
#ifndef REP_G1
#define REP_G1 1
#endif
#ifndef REP_LRU
#define REP_LRU 1
#endif
#ifndef REP_ATT
#define REP_ATT 1
#endif
#ifndef REP_FIX
#define REP_FIX 1
#endif
#ifndef G1_ALIGN
#define G1_ALIGN true
#endif
#ifndef G1_SP2
#define G1_SP2 true
#endif
#ifndef G2_ALIGN
#define G2_ALIGN true
#endif
#ifndef G2_SP2
#define G2_SP2 true
#endif
constexpr int NPL = 6;
constexpr int NPHASE = 2 + NPL * DEPTH + 1;
__global__ void __launch_bounds__(NWAVES * 64, 2) trunk_fwd(Args args) {
    extern __shared__ __attribute__((aligned(16))) unsigned char lds[];
    Frame F;
    F.lds = (LAS unsigned char*)lds;
    F.MISC = (volatile LAS unsigned*)(F.lds + MISC_OFF);
    F.tid = threadIdx.x; F.lane = F.tid & 63; F.wave = __builtin_amdgcn_readfirstlane(F.tid >> 6);
    F.G = gridDim.x; { const int bx = blockIdx.x; F.vcu = (F.G % 8 == 0) ? (bx % 8) * (F.G / 8) + bx / 8 : bx; }
    KArgs A_ = (KArgs)__builtin_amdgcn_kernarg_segment_ptr(); KArgs A = A_;
    for (int u = F.tid; u < (LDS_BYTES - LDSCTL_OFF) / 4; u += NWAVES * 64) ((LAS unsigned*)(F.lds + LDSCTL_OFF))[u] = 0u;
    __syncthreads();
    XcdBarrier bar = xcd_barrier_post((unsigned*)(F_ctl + CW_BAR) + args.li * XCD_BAR_WORDS, F.MISC + 8);
    F.cid = (int)blockIdx.x;
    if (F.tid == 0) F.MISC[10] = __hip_atomic_fetch_add((unsigned*)(F_ctl + CW_RANK + 64 * (int)bar.x), 1u, __ATOMIC_RELAXED, __HIP_MEMORY_SCOPE_AGENT);
#ifndef REP_BAR
#define REP_BAR 1
#endif
#define GRID_BAR() do { for (int rb_ = 0; rb_ < REP_BAR; ++rb_) xcd_barrier(bar); } while (0)
    const int lo = args.ph_lo, hi = args.ph_hi;
#define IN(k) (lo <= (k) && (k) < hi)
#define BOTH(k) (IN(k) && IN((k) + 1))

    if (IN(0)) { for (int rep = 0; rep < REP_P0A; ++rep) p0_mod_phase(F, A); if (BOTH(0)) GRID_BAR(); }
    if (BOTH(0)) {
        if (F.tid == 0) { bool uni = (F.G == 256);
            for (int j = 0; j < 16; ++j) { const unsigned cnt = xb_ld(&bar.bar[XB_XCNT(j)]); uni = uni && (cnt == (j < 8 ? 32u : 0u)); }
            F.MISC[11] = uni ? (F.MISC[10] * 8u + bar.x) : (unsigned)blockIdx.x; }
        __syncthreads();
        F.cid = (int)F.MISC[11];
        F.vcu = (F.G % 8 == 0) ? (F.cid % 8) * (F.G / 8) + F.cid / 8 : F.cid;
    }

    if (IN(1)) { for (int rep = 0; rep < REP_P0; ++rep) p0_convert_phase(F, A);
        for (int rep = 0; rep < REP_NORM; ++rep) norm0_phase(F, A, F_x, 0);
        if (BOTH(1)) GRID_BAR(); }

    for (int l = 0; l < DEPTH; ++l) {
        const int pb = 2 + NPL * l;
        const float* xin = (l == 0) ? F_x : F_out;
        if (IN(pb + 1)) {
            KArgs A = A_; asm volatile("" : "+s"(A));
            pg8::Gemm g{F_HB, F_WIN + (size_t)l * DIN * D, M, DIN, D}; pg8::StaticOrder S; S.init(M, DIN, F.G, F.cid);
            pg8::Unit u0; S.next(0, u0);
            { LAS float* rt = (LAS float*)(F.lds + RTAB_OFF); const int t2 = launder_v((int)threadIdx.x);
              if (t2 < 256) { const f32x4* rp = (const f32x4*)(F_RS + (size_t)(u0.pm * 256 + t2) * 64); float s = 0.f;
#pragma unroll
                  for (int i = 0; i < 16; ++i) { const f32x4 v = rp[i]; s += (v.x + v.y) + (v.z + v.w); }
                  rt[t2] = 1.0f / sqrtf(s * (1.f / D) + EPS); }
              __syncthreads(); }
            pg8::EpiBf16N E{F_PB, M, F_SW + (size_t)(l * 2) * DIN, DIN, (const LAS float*)(F.lds + RTAB_OFF)};
            for (int rep = 0; rep < REP_G1; ++rep) pg8::gemm_phase<pg8::EpiBf16N, pg8::StaticOrder, G1_ALIGN, G1_SP2>(F.lds + RING_OFF, g, S, E);
            if (BOTH(pb + 1)) GRID_BAR();
        }
        if (IN(pb + 2)) { for (int rep = 0; rep < REP_LRU; ++rep) lru_local_phase(F, A, l); for (int rep = 0; rep < REP_ATT; ++rep) attn_phase(F, A, l); for (int rep = 0; rep < REP_FIX; ++rep) lru_fix_phase(F, A, l); if (BOTH(pb + 2)) GRID_BAR(); }
        if (IN(pb + 5)) {
            KArgs A = A_; asm volatile("" : "+s"(A));
            pg8::Gemm g{F_YC, F_WOUT + (size_t)l * D * D, M, D, D}; pg8::StaticOrder S; S.init(M, D, F.G, F.cid);
            pg8::Unit u0; S.next(0, u0);
            { LAS float* rt = (LAS float*)(F.lds + RTAB_OFF); const int t2 = launder_v((int)threadIdx.x);
              if (t2 < 256) { const f32x4* pa = (const f32x4*)(F_SSA + (size_t)(u0.pm * 256 + t2) * NBLK); const f32x4* pb_ = (const f32x4*)(F_SSQ + (size_t)(u0.pm * 256 + t2) * NH); float sa = 0.f, sb = 0.f;
#pragma unroll
                  for (int i = 0; i < 4; ++i) { const f32x4 va = pa[i], vb = pb_[i]; sa += (va.x + va.y) + (va.z + va.w); sb += (vb.x + vb.y) + (vb.z + vb.w); }
                  const float ra = 1.0f / sqrtf(sa * (1.f / WL) + EPS), rb = 1.0f / sqrtf(sb * (1.f / WA) + EPS);
                  rt[t2] = rb / ra; rt[256 + t2] = ra; }
              __syncthreads(); }
            const bool more = (l + 1 < DEPTH);
            pg8::EpiResid E{F_x, F_out, D, F_MOD + (size_t)(l * 2) * (3 * D) + 2 * D, 3 * D, (const LAS float*)(F.lds + RTAB_OFF),
                            (l > 0) ? F_XB : (const bf16*)nullptr, more ? F_XB : (bf16*)nullptr,
                            more ? F_HB : (bf16*)nullptr, F_norm_g + (size_t)(more ? l + 1 : l) * D, F_MOD + (size_t)((more ? l + 1 : l) * 2) * (3 * D) + D, 3 * D, F_RS};
#ifndef REP_G2L0
#define REP_G2L0 1
#endif
            for (int rep = 0; rep < ((l == 0) ? REP_G2L0 : 1); ++rep) pg8::gemm_phase<pg8::EpiResid, pg8::StaticOrder, G2_ALIGN, G2_SP2>(F.lds + RING_OFF, g, S, E);
            if (BOTH(pb + 5)) GRID_BAR();
        }
    }
    if (IN(NPHASE - 1)) final_norm_phase(F, A, F_out);
#undef IN
#undef BOTH
}

#ifndef MK_SPLIT
#define MK_SPLIT 0
#endif
extern "C" void kernel_launch(void* const* d_in, const int* in_sizes, int n_in, void* d_out, int out_size, void* d_ws, size_t ws_size, hipStream_t stream) {
    static int grid = 0;
    if (grid == 0) {
        if (n_in != 18 || in_sizes[0] != M * D || out_size != M * D || ws_size < WS_END) { fprintf(stderr, "kernel_launch: unexpected shapes (n_in %d, in0 %d, out %d, ws %zu); nothing launched\n", n_in, n_in > 0 ? in_sizes[0] : -1, out_size, ws_size); grid = -1; return; }
        int dev = 0, cus = 0, per_cu = 0;
        if (hipGetDevice(&dev) != hipSuccess || hipDeviceGetAttribute(&cus, hipDeviceAttributeMultiprocessorCount, dev) != hipSuccess) { fprintf(stderr, "kernel_launch: device query failed\n"); grid = -1; return; }
        if (hipFuncSetAttribute((const void*)trunk_fwd, hipFuncAttributeMaxDynamicSharedMemorySize, LDS_BYTES) != hipSuccess) { fprintf(stderr, "kernel_launch: hipFuncSetAttribute failed\n"); grid = -1; return; }
        if (hipOccupancyMaxActiveBlocksPerMultiprocessor(&per_cu, (const void*)trunk_fwd, NWAVES * 64, LDS_BYTES) != hipSuccess || per_cu < 1)
            fprintf(stderr, "kernel_launch: note: occupancy query reports %d workgroups per CU\n", per_cu);
        (void)hipGetLastError();
        grid = cus;
        if (cus != 256) { fprintf(stderr, "kernel_launch: built for a 256-CU device (unit orders, prologue partition); found %d CUs; nothing launched\n", cus); grid = -1; return; }
    }
    if (grid < 0) return;
    if (hipMemsetAsync((char*)d_ws + WS_CTL, 0, CTL_ZERO_BYTES, stream) != hipSuccess) { fprintf(stderr, "kernel_launch: memset failed\n"); return; }
    Args a{};
    for (int i = 0; i < 18; ++i) a.in[i] = (const float*)d_in[i];
    a.out = (float*)d_out; a.ws = (unsigned char*)d_ws; a.pad = 0;
#if MK_SPLIT
    for (int p = 0; p < NPHASE; ++p) { a.ph_lo = p; a.ph_hi = p + 1; a.li = p;
        hipLaunchKernelGGL(trunk_fwd, dim3(grid), dim3(NWAVES * 64), LDS_BYTES, stream, a);
        const hipError_t le = hipPeekAtLastError();
        if (le != hipSuccess) { fprintf(stderr, "kernel_launch: launch %d failed: %s\n", p, hipGetErrorName(le)); break; } }
#else
    a.ph_lo = 0; a.ph_hi = NPHASE; a.li = 0;
    hipLaunchKernelGGL(trunk_fwd, dim3(grid), dim3(NWAVES * 64), LDS_BYTES, stream, a);
    { const hipError_t le = hipPeekAtLastError(); if (le != hipSuccess) fprintf(stderr, "kernel_launch: launch failed: %s\n", hipGetErrorName(le)); }
#endif
}
```

```cpp
#include <hip/hip_runtime.h>
#include <cstdio>
#include <cstdint>

namespace pg8 {
#define PG8_LAS __attribute__((address_space(3)))
typedef unsigned short bf16_t;
typedef short bf16x8 __attribute__((ext_vector_type(8)));
typedef float f32x4 __attribute__((ext_vector_type(4)));
typedef unsigned u32x4 __attribute__((ext_vector_type(4)));
constexpr int BM = 256, BK = 64, HALF = 128, HTB = HALF * BK * 2  , STAGE_BYTES = 8 * HTB, NXCD = 8;
#ifndef PG8_WGM
#define PG8_WGM 8
#endif
constexpr int WGM = PG8_WGM;

__host__ __device__ __forceinline__ int lds_byte(int r, int c) { const int st = (r >> 4) * 2 + (c >> 5), rr = r & 15, cc = c & 31, ob = rr * 64 + cc * 2; return st * 1024 + (ob ^ (((ob >> 9) & 1) << 5)); }
__host__ __device__ __forceinline__ void stage_rc(int b, int& R, int& C) { const int st = b / 1024, sb = b % 1024, swz = sb ^ (((sb >> 9) & 1) << 5); R = (st >> 1) * 16 + swz / 64; C = (st & 1) * 32 + (swz % 64) / 2; }
__host__ __device__ __forceinline__ int perm32(int rho) { const int n = rho >> 4, i = rho & 15; return 8 * (i >> 2) + 4 * n + (i & 3); }

struct Unit { int pm, pn; };
struct Gemm { const bf16_t* A; const bf16_t* Bt; int M, N, K; };

struct StaticOrder {
    int nM, nN, nwg, G, c;
    __host__ __device__ void init(int M, int N, int G_, int c_) { nM = M / BM; nN = N / BM; nwg = nM * nN; G = G_; c = c_; }
    __host__ __device__ bool next(int i, Unit& u) const {
        const long L = (long)i * G + c; if (L >= nwg) return false;
        int wgid = (int)L; { const int q = nwg / NXCD, r = nwg % NXCD, xcd = wgid % NXCD, off = wgid / NXCD; wgid = (xcd < r ? xcd * (q + 1) : r * (q + 1) + (xcd - r) * q) + off; }
        const int nig = WGM * nN, gid = wgid / nig, fm = gid * WGM, gsz = (nM - fm) < WGM ? (nM - fm) : WGM;
        u.pm = fm + ((wgid % nig) % gsz); u.pn = (wgid % nig) / gsz; return true;
    }
    __device__ __forceinline__ void a_ready(const Unit&) const {}
    __device__ __forceinline__ void done(const Unit&) const {}
};

__device__ __forceinline__ unsigned cvt_pk_bf16(float lo, float hi) { unsigned r; asm volatile("v_cvt_pk_bf16_f32 %0, %1, %2" : "=v"(r) : "v"(lo), "v"(hi)); return r; }
typedef float f32x2 __attribute__((ext_vector_type(2)));

struct EpiBf16N {
    static constexpr bool PERM = true, AFTER_DRAIN = false, MIDK = false;
    bf16_t* O; int ldc; const float* sw; int swpitch; const PG8_LAS float* rtab;
    __device__ __forceinline__ void operator()(const f32x4 (&acc)[2][2][4][2], const Unit& u, int wr, int wc, int fr, int fq) const {
        const int row0 = u.pm * BM + wr * 64 + fr; const int col0 = u.pn * BM + wc * 32 + 8 * fq;
        const float* swp = sw + (size_t)((u.pm * BM) >> 12) * swpitch + col0;
        f32x4 sv[2][2];
#pragma unroll
        for (int bj = 0; bj < 2; ++bj)
#pragma unroll
            for (int n = 0; n < 2; ++n) sv[bj][n] = *(const f32x4*)(swp + bj * HALF + 4 * n);
#pragma unroll
        for (int ai = 0; ai < 2; ++ai)
#pragma unroll
            for (int m = 0; m < 4; ++m) { bf16_t* rowp = O + ((size_t)(2 * u.pn) * ldc + (row0 + ai * HALF + m * 16)) * 128 + (wc * 32 + 8 * fq); const float rs = rtab[ai * HALF + wr * 64 + m * 16 + fr];
#pragma unroll
                for (int bj = 0; bj < 2; ++bj) { const f32x4 v0 = acc[ai][bj][m][0] * rs + sv[bj][0], v1 = acc[ai][bj][m][1] * rs + sv[bj][1];
                    u32x4 w; w.x = cvt_pk_bf16(v0[0], v0[1]); w.y = cvt_pk_bf16(v0[2], v0[3]); w.z = cvt_pk_bf16(v1[0], v1[1]); w.w = cvt_pk_bf16(v1[2], v1[3]);
                    *(u32x4*)(rowp + (size_t)bj * ldc * 128) = w;
                    } }
    }
};
constexpr int M_ROWS = 8192;
struct EpiResid {
    static constexpr bool PERM = true, AFTER_DRAIN = false, MIDK = true;
    const float* xin; float* xout; int ldc; const float* gate; int gpitch; const PG8_LAS float* rtab;
    const bf16_t* xin16; bf16_t* xout16;
    bf16_t* hn; const float* gnext; const float* sclnext; int spitch; float* rs;
    __device__ __forceinline__ void midk(f32x4 (&acc)[2][2][4][2], const Unit& u, int wr, int fr) const {
#pragma unroll
        for (int ai = 0; ai < 2; ++ai)
#pragma unroll
            for (int m = 0; m < 4; ++m) { const float s = rtab[ai * HALF + wr * 64 + m * 16 + fr];
#pragma unroll
                for (int bj = 0; bj < 2; ++bj)
#pragma unroll
                    for (int n = 0; n < 2; ++n) acc[ai][bj][m][n] *= s; }
    }
    __device__ __forceinline__ void operator()(const f32x4 (&acc)[2][2][4][2], const Unit& u, int wr, int wc, int fr, int fq) const {
        const int row0 = u.pm * BM + wr * 64 + fr, col0 = u.pn * BM + wc * 32 + 8 * fq;
        const float* gp = gate + (size_t)((u.pm * BM) >> 12) * gpitch + col0;
        f32x4 gv[2][2], gs[2][2];
        const bool nx = (hn != nullptr);
#pragma unroll
        for (int bj = 0; bj < 2; ++bj)
#pragma unroll
            for (int n = 0; n < 2; ++n) { gv[bj][n] = *(const f32x4*)(gp + bj * HALF + 4 * n);
                gs[bj][n] = (f32x4){0.f, 0.f, 0.f, 0.f};
                if (nx) gs[bj][n] = *(const f32x4*)(gnext + col0 + bj * HALF + 4 * n) * (*(const f32x4*)(sclnext + (size_t)((u.pm * BM) >> 12) * spitch + col0 + bj * HALF + 4 * n) + 1.0f); }
#ifndef XW_DEPTH
#define XW_DEPTH 0
#endif
#pragma unroll
        for (int ai = 0; ai < 2; ++ai) {
            u32x4 xw[4][2];
            if (xin16) {
#pragma unroll
                for (int m = 0; m < XW_DEPTH; ++m)
#pragma unroll
                    for (int bj = 0; bj < 2; ++bj) xw[m][bj] = *(const u32x4*)(xin16 + ((size_t)((col0 + bj * HALF) >> 6) * M_ROWS + (row0 + ai * HALF + m * 16)) * 64 + ((col0 + bj * HALF) & 63));
            }
#pragma unroll
            for (int m = 0; m < 4; ++m) {
                const size_t off = (size_t)(row0 + ai * HALF + m * 16) * ldc + col0; float q = 0.f;
                const float ra = rtab[256 + ai * HALF + wr * 64 + m * 16 + fr];
                f32x4 xi[2][2];
                if (xin16) {
#pragma unroll
                    for (int bj = 0; bj < 2; ++bj) { u32x4 w;
                        if (m < XW_DEPTH) w = xw[m][bj]; else w = *(const u32x4*)(xin16 + ((size_t)((col0 + bj * HALF) >> 6) * M_ROWS + (row0 + ai * HALF + m * 16)) * 64 + ((col0 + bj * HALF) & 63));
                        xi[bj][0] = (f32x4){__builtin_bit_cast(float, w.x << 16), __builtin_bit_cast(float, w.x & 0xffff0000u), __builtin_bit_cast(float, w.y << 16), __builtin_bit_cast(float, w.y & 0xffff0000u)};
                        xi[bj][1] = (f32x4){__builtin_bit_cast(float, w.z << 16), __builtin_bit_cast(float, w.z & 0xffff0000u), __builtin_bit_cast(float, w.w << 16), __builtin_bit_cast(float, w.w & 0xffff0000u)}; }
                } else {
#pragma unroll
                    for (int bj = 0; bj < 2; ++bj)
#pragma unroll
                        for (int n = 0; n < 2; ++n) xi[bj][n] = *(const f32x4*)(xin + off + bj * HALF + 4 * n);
                }
#pragma unroll
                for (int bj = 0; bj < 2; ++bj) { f32x4 xo[2];
#pragma unroll
                    for (int n = 0; n < 2; ++n) xo[n] = xi[bj][n] + gv[bj][n] * (acc[ai][bj][m][n] * ra);
                    if (xout16) { u32x4 w; w.x = cvt_pk_bf16(xo[0][0], xo[0][1]); w.y = cvt_pk_bf16(xo[0][2], xo[0][3]); w.z = cvt_pk_bf16(xo[1][0], xo[1][1]); w.w = cvt_pk_bf16(xo[1][2], xo[1][3]);
                        *(u32x4*)(xout16 + ((size_t)((col0 + bj * HALF) >> 6) * M_ROWS + (row0 + ai * HALF + m * 16)) * 64 + ((col0 + bj * HALF) & 63)) = w; }
                    else { *(f32x4*)(xout + off + bj * HALF) = xo[0]; *(f32x4*)(xout + off + bj * HALF + 4) = xo[1]; }
                    if (nx) { q += ((xo[0][0] * xo[0][0] + xo[0][1] * xo[0][1]) + (xo[0][2] * xo[0][2] + xo[0][3] * xo[0][3])) + ((xo[1][0] * xo[1][0] + xo[1][1] * xo[1][1]) + (xo[1][2] * xo[1][2] + xo[1][3] * xo[1][3]));
                        const f32x4 h0 = xo[0] * gs[bj][0], h1 = xo[1] * gs[bj][1];
                        u32x4 w; w.x = cvt_pk_bf16(h0[0], h0[1]); w.y = cvt_pk_bf16(h0[2], h0[3]); w.z = cvt_pk_bf16(h1[0], h1[1]); w.w = cvt_pk_bf16(h1[2], h1[3]);
                        *(u32x4*)(hn + ((size_t)((col0 + bj * HALF) >> 6) * M_ROWS + (row0 + ai * HALF + m * 16)) * 64 + ((col0 + bj * HALF) & 63)) = w; } }
                if (nx) { q += __shfl_xor(q, 16); q += __shfl_xor(q, 32);
                    if (fq == 0) rs[(size_t)(row0 + ai * HALF + m * 16) * 64 + u.pn * 4 + wc] = q; }
                asm volatile("" ::: "memory"); } }
    }
};


template <class Epi, class Sched, bool ALIGN_EPI = false, bool SP2 = false>
__device__ __forceinline__ void gemm_phase(PG8_LAS unsigned char* lds, const Gemm g, const Sched& S, const Epi& E) {
    int tid_ = threadIdx.x; asm volatile("" : "+v"(tid_));
    const int tid = tid_, wid = __builtin_amdgcn_readfirstlane(tid >> 6), lane = tid & 63, wr = wid >> 2, wc = wid & 3, fr = lane & 15, fq = lane >> 4;
    const int K = g.K, nt = K / BK;
    unsigned voffA[2], voffB[2];
#pragma unroll
    for (int i = 0; i < 2; ++i) { int R, C; stage_rc(tid * 16 + i * 8192, R, C); const int Rb = Epi::PERM ? ((R & ~31) + perm32(R & 31)) : R;
        voffA[i] = (unsigned)(R * BK + C) * 2u; voffB[i] = (unsigned)(Rb * BK + C) * 2u; }
    const size_t kstepB = (size_t)g.N * BK * 2, hstepB = (size_t)HALF * BK * 2, tstepB = 2 * hstepB;
    const size_t kstepA = (size_t)g.M * BK * 2, hstepA = hstepB, tstepA = tstepB;
    const unsigned ldsw = (unsigned)wid * 1024u;
    const int aoff = lds_byte(wr * 64 + fr, fq * 8), boff = lds_byte(wc * 32 + fr, fq * 8);
#define PG8_SA(b, h) (((b) * 2 + (h)) * HTB)
#define PG8_SB(b, h) ((4 + (b) * 2 + (h)) * HTB)
#define PG8_STAGE(bufoff, gbase, voff) do { _Pragma("unroll") for (int _i = 0; _i < 2; ++_i) \
        __builtin_amdgcn_global_load_lds((const unsigned*)((const char*)(gbase) + (voff)[_i]), (PG8_LAS unsigned*)(lds + (bufoff) + ldsw + _i * 8192), 16, 0, 0); } while (0)
#define PG8_LDA(dst, b, h) do { _Pragma("unroll") for (int m = 0; m < 4; ++m) _Pragma("unroll") for (int k = 0; k < 2; ++k) dst[m][k] = *(const PG8_LAS bf16x8*)(lds + PG8_SA(b, h) + aoff + m * 2048 + k * 1024); } while (0)
#define PG8_LDB(dst, b, h) do { _Pragma("unroll") for (int n = 0; n < 2; ++n) _Pragma("unroll") for (int k = 0; k < 2; ++k) dst[n][k] = *(const PG8_LAS bf16x8*)(lds + PG8_SB(b, h) + boff + n * 2048 + k * 1024); } while (0)
#define PG8_MMA(ai, bj, At, Bt) do { __builtin_amdgcn_s_setprio(1); _Pragma("unroll") for (int m = 0; m < 4; ++m) _Pragma("unroll") for (int n = 0; n < 2; ++n) _Pragma("unroll") for (int k = 0; k < 2; ++k) \
        acc[ai][bj][m][n] = __builtin_amdgcn_mfma_f32_16x16x32_bf16(Bt[n][k], At[m][k], acc[ai][bj][m][n], 0, 0, 0); __builtin_amdgcn_s_setprio(0); } while (0)
#define PG8_WAIT_V(n) asm volatile("s_waitcnt vmcnt(" #n ")" ::: "memory")
#define PG8_WAIT_L(n) asm volatile("s_waitcnt lgkmcnt(" #n ")" ::: "memory")
#define PG8_BAR __builtin_amdgcn_s_barrier()
#define PG8_SCHED __builtin_amdgcn_sched_barrier(0)
    Unit cur, nxt; int ui = 0;
    if (!S.next(0, cur)) return;
    f32x4 acc[2][2][4][2];
#pragma unroll
    for (int a = 0; a < 2; ++a)
#pragma unroll
        for (int b = 0; b < 2; ++b)
#pragma unroll
            for (int m = 0; m < 4; ++m)
#pragma unroll
                for (int n = 0; n < 2; ++n) acc[a][b][m][n] = (f32x4){0.f, 0.f, 0.f, 0.f};
    bf16x8 At[4][2], B0[2][2], B1[2][2];
    const char* cA = (const char*)g.A + (size_t)cur.pm * tstepA; const char* cB = (const char*)g.Bt + (size_t)cur.pn * tstepB;
    S.a_ready(cur);
    if constexpr (SP2) {
        PG8_STAGE(PG8_SB(0, 0), cB, voffB); PG8_STAGE(PG8_SB(0, 1), cB + hstepB, voffB); PG8_STAGE(PG8_SA(0, 0), cA, voffA); PG8_STAGE(PG8_SA(0, 1), cA + hstepA, voffA);
        if (wr == 1) PG8_BAR;
        PG8_WAIT_V(2); PG8_BAR;
        PG8_STAGE(PG8_SB(1, 0), cB + kstepB, voffB); PG8_STAGE(PG8_SA(1, 0), cA + kstepA, voffA); PG8_STAGE(PG8_SB(1, 1), cB + hstepB + kstepB, voffB);
        PG8_WAIT_V(6); PG8_BAR;
    } else {
        PG8_STAGE(PG8_SB(0, 0), cB, voffB); PG8_STAGE(PG8_SA(0, 0), cA, voffA); PG8_STAGE(PG8_SB(0, 1), cB + hstepB, voffB); PG8_STAGE(PG8_SA(0, 1), cA + hstepA, voffA);
        if (wr == 1) PG8_BAR;
        PG8_WAIT_V(4); PG8_BAR;
        PG8_STAGE(PG8_SB(1, 0), cB + kstepB, voffB); PG8_STAGE(PG8_SA(1, 0), cA + kstepA, voffA); PG8_STAGE(PG8_SB(1, 1), cB + hstepB + kstepB, voffB);
        PG8_WAIT_V(6); PG8_BAR;
    }
    for (;;) {
        const bool has_next = S.next(ui + 1, nxt);
        const char* nA = has_next ? (const char*)g.A + (size_t)nxt.pm * tstepA : cA; const char* nB = has_next ? (const char*)g.Bt + (size_t)nxt.pn * tstepB : cB;
        for (int t = 0; t < nt; t += 2) {
            const bool last = (t == nt - 2);
            const char* a1 = cA + (size_t)(t + 1) * kstepA;
            const char* a2 = last ? nA : cA + (size_t)(t + 2) * kstepA; const char* b2 = last ? nB : cB + (size_t)(t + 2) * kstepB;
            const char* a3 = a2 + kstepA; const char* b3 = b2 + kstepB;
            if (last && has_next) S.a_ready(nxt);
            if constexpr (Epi::MIDK) { if (t == nt / 2) E.midk(acc, cur, wr, fr); }
            if constexpr (SP2) {
            PG8_LDB(B0, 0, 0); PG8_LDB(B1, 0, 1); PG8_SCHED; PG8_LDA(At, 0, 0); PG8_STAGE(PG8_SA(1, 1), a1 + hstepA, voffA);
            PG8_WAIT_V(8); PG8_WAIT_L(0); PG8_BAR; PG8_MMA(0, 0, At, B0); PG8_MMA(0, 1, At, B1); PG8_BAR; PG8_SCHED;
            PG8_LDA(At, 0, 1); PG8_STAGE(PG8_SB(0, 0), b2, voffB); PG8_STAGE(PG8_SB(0, 1), b2 + hstepB, voffB); PG8_STAGE(PG8_SA(0, 0), a2, voffA);
            PG8_WAIT_V(8); PG8_WAIT_L(0); PG8_BAR; PG8_MMA(1, 0, At, B0); PG8_MMA(1, 1, At, B1); PG8_BAR; PG8_SCHED;
            PG8_LDB(B0, 1, 0); PG8_LDB(B1, 1, 1); PG8_SCHED; PG8_LDA(At, 1, 0); PG8_STAGE(PG8_SA(0, 1), a2 + hstepA, voffA);
            PG8_WAIT_V(8); PG8_WAIT_L(0); PG8_BAR; PG8_MMA(0, 0, At, B0); PG8_MMA(0, 1, At, B1); PG8_BAR; PG8_SCHED;
            PG8_LDA(At, 1, 1); PG8_STAGE(PG8_SB(1, 0), b3, voffB); PG8_STAGE(PG8_SB(1, 1), b3 + hstepB, voffB); PG8_STAGE(PG8_SA(1, 0), a3, voffA);
            PG8_WAIT_V(8); PG8_WAIT_L(0); PG8_BAR; PG8_MMA(1, 0, At, B0); PG8_MMA(1, 1, At, B1); PG8_BAR; PG8_SCHED;
            } else {
            PG8_LDB(B0, 0, 0); PG8_SCHED; PG8_LDA(At, 0, 0); PG8_STAGE(PG8_SA(1, 1), a1 + hstepA, voffA);
            PG8_WAIT_L(8); PG8_BAR; PG8_WAIT_L(0); PG8_MMA(0, 0, At, B0); PG8_BAR; PG8_SCHED;
            PG8_LDB(B1, 0, 1); PG8_STAGE(PG8_SB(0, 0), b2, voffB);
            PG8_BAR; PG8_WAIT_L(0); PG8_MMA(0, 1, At, B1); PG8_BAR;
            PG8_LDA(At, 0, 1); PG8_STAGE(PG8_SA(0, 0), a2, voffA);
            PG8_BAR; PG8_WAIT_L(0); PG8_MMA(1, 0, At, B0); PG8_BAR; PG8_SCHED;
            PG8_STAGE(PG8_SB(0, 1), b2 + hstepB, voffB);
            PG8_WAIT_V(6); PG8_BAR; PG8_MMA(1, 1, At, B1); PG8_BAR;
            PG8_LDB(B0, 1, 0); PG8_SCHED; PG8_LDA(At, 1, 0); PG8_STAGE(PG8_SA(0, 1), a2 + hstepA, voffA);
            PG8_WAIT_L(8); PG8_BAR; PG8_WAIT_L(0); PG8_MMA(0, 0, At, B0); PG8_BAR; PG8_SCHED;
            PG8_LDB(B1, 1, 1); PG8_STAGE(PG8_SB(1, 0), b3, voffB);
            PG8_BAR; PG8_WAIT_L(0); PG8_MMA(0, 1, At, B1); PG8_BAR;
            PG8_LDA(At, 1, 1); PG8_STAGE(PG8_SA(1, 0), a3, voffA);
            PG8_BAR; PG8_WAIT_L(0); PG8_MMA(1, 0, At, B0); PG8_BAR; PG8_SCHED;
            PG8_STAGE(PG8_SB(1, 1), b3 + hstepB, voffB);
            PG8_WAIT_V(6); PG8_BAR; PG8_MMA(1, 1, At, B1); PG8_BAR;
            }
        }
        if constexpr (ALIGN_EPI) { if (wr == 0) PG8_BAR; }
        if constexpr (!Epi::AFTER_DRAIN) { E(acc, cur, wr, wc, fr, fq); S.done(cur); }
        if (!has_next) break;
#pragma unroll
        for (int a = 0; a < 2; ++a)
#pragma unroll
            for (int b = 0; b < 2; ++b)
#pragma unroll
                for (int m = 0; m < 4; ++m)
#pragma unroll
                    for (int n = 0; n < 2; ++n) acc[a][b][m][n] = (f32x4){0.f, 0.f, 0.f, 0.f};
        cur = nxt; cA = nA; cB = nB; ++ui;
        if constexpr (ALIGN_EPI) { if (wr == 1) PG8_BAR; }
    }
    PG8_WAIT_V(0);
    if constexpr (!ALIGN_EPI) { if (wr == 0) PG8_BAR; }
    PG8_BAR;
    if constexpr (Epi::AFTER_DRAIN) { E.fused(acc, cur, wr, wc, fr, fq, lds, wid, lane); S.done(cur); }
#undef PG8_SA
#undef PG8_SB
#undef PG8_STAGE
#undef PG8_LDA
#undef PG8_LDB
#undef PG8_MMA
#undef PG8_WAIT_V
#undef PG8_WAIT_L
#undef PG8_BAR
#undef PG8_SCHED
}
}

#ifndef PG8_SP2
#define PG8_SP2 true
#endif
#ifndef PG8_ALIGN
#define PG8_ALIGN true
#endif

constexpr int NWAVES = 8;
constexpr int D = 4096, BATCH = 2, SEQ = 4096, DEPTH = 4, M = BATCH * SEQ;
constexpr int WL = 2048, WA = 2048, NBLK = 16, BW = 128, NH = 16, HD = 128, GW = 64, ROWS = 64, KR = 8, KC = 16;
constexpr int DIN = 2 * WL + 4 * WA;
constexpr int PP = DIN + 128;
constexpr int OFF_XA = 0, OFF_GA = WL, OFF_Q = 2 * WL, OFF_K = 2 * WL + WA, OFF_V = 2 * WL + 2 * WA, OFF_GB = 2 * WL + 3 * WA;
constexpr float EPS = 1e-6f, C_RG = 8.0f;
constexpr int TC = 64, NCH = SEQ / TC;

constexpr size_t MiB = 1u << 20;
constexpr size_t WS_CTL = 0, CTL_ZERO_BYTES = 1 * MiB;
constexpr size_t WS_MOD = 1 * MiB;
constexpr size_t WS_SW = 1 * MiB + 512 * 1024;
constexpr size_t WS_WAT = 2 * MiB, WS_WXT = 6 * MiB;
constexpr size_t WS_WIN = 16 * MiB;
constexpr size_t WS_WOUT = 400 * MiB;
constexpr size_t WS_H = 528 * MiB;
constexpr size_t WS_P = 1088 * MiB;
constexpr size_t WS_YC = 784 * MiB;
constexpr size_t WS_LH = 848 * MiB, WS_PF = 912 * MiB, WS_PB = 976 * MiB;
constexpr size_t WS_SUM = 1040 * MiB;
constexpr size_t WS_CAR = 1048 * MiB;
constexpr size_t WS_YB = 1052 * MiB;
constexpr size_t WS_SSQ = 1084 * MiB;
constexpr size_t WS_SSA = 1085 * MiB + 512 * 1024;
constexpr size_t WS_XB = 1284 * MiB;
constexpr size_t WS_RS = 1086 * MiB;
constexpr size_t WS_END = 1348 * MiB;
static_assert(WS_SUM + (size_t)BATCH * NCH * 2 * WL * 2 * 4 <= WS_CAR && WS_CAR + (size_t)BATCH * NCH * 2 * WL * 4 <= WS_YB && WS_YB + (size_t)M * WA * 2 <= WS_SSQ && WS_SSQ + (size_t)M * NH * 4 <= WS_END, "d_ws map (scan scratch)");
static_assert(WS_MOD + (size_t)DEPTH * 2 * 3 * D * 4 <= WS_SW && WS_SW + (size_t)DEPTH * 2 * DIN * 4 <= WS_WAT && WS_WAT + (size_t)DEPTH * 2 * NBLK * BW * BW * 2 <= WS_WXT && WS_WXT + (size_t)DEPTH * 2 * NBLK * BW * BW * 2 <= WS_WIN, "d_ws map (small)");
static_assert(WS_WIN + (size_t)DEPTH * DIN * D * 2 <= WS_WOUT && WS_WOUT + (size_t)DEPTH * D * D * 2 <= WS_H && WS_H + (size_t)M * D * 2 <= WS_YC && WS_P + (size_t)M * PP * 2 <= WS_END && WS_YC + (size_t)M * D * 2 <= WS_LH, "d_ws map (big)");
static_assert(WS_LH + (size_t)M * WL * 4 <= WS_PF && WS_PF + (size_t)M * WL * 4 <= WS_PB && WS_PB + (size_t)M * WL * 4 <= WS_SUM, "d_ws map (lru)");
constexpr int CW_TMO = 0, CW_CODE = 1;
constexpr int CW_CARRY = 1024;
constexpr int CW_CREADY = 3072;
constexpr int CW_RANK = 2048;
constexpr int CW_BAR = 4096;

constexpr int RING_OFF = 0, RING_BYTES = 131072;
constexpr int LDS_BYTES = 147456;
constexpr int LDSCTL_OFF = LDS_BYTES - 3072, MISC_OFF = LDSCTL_OFF + 320;
constexpr int RTAB_OFF = LDSCTL_OFF + 1024;
constexpr int PHASE_LDS = LDSCTL_OFF;
static_assert(RING_BYTES <= PHASE_LDS && MISC_OFF + 128 <= RTAB_OFF && RTAB_OFF + 2048 <= LDS_BYTES, "LDS map");

#define GAS __attribute__((address_space(1)))
#define LAS __attribute__((address_space(3)))
typedef unsigned short bf16;
typedef unsigned v4u __attribute__((ext_vector_type(4)));
typedef unsigned v2u __attribute__((ext_vector_type(2)));
typedef float f32x4 __attribute__((ext_vector_type(4)));
typedef short bf16x8 __attribute__((ext_vector_type(8)));
typedef GAS unsigned gu32;
typedef GAS unsigned long long gu64;
#define RLX_AGENT __ATOMIC_RELAXED, __HIP_MEMORY_SCOPE_AGENT
#define LDS_WAIT() asm volatile("s_waitcnt lgkmcnt(0)" ::: "memory")
#define VM_WAIT() asm volatile("s_waitcnt vmcnt(0)" ::: "memory")
__device__ __forceinline__ unsigned f2bf(float f) { unsigned u = __builtin_bit_cast(unsigned, f); return (u + 0x7fffu + ((u >> 16) & 1u)) >> 16; }
typedef float f32x2_t __attribute__((ext_vector_type(2))); typedef __bf16 bf16x2_t __attribute__((ext_vector_type(2)));
__device__ __forceinline__ unsigned pk2(float lo, float hi) { const f32x2_t v = {lo, hi}; return __builtin_bit_cast(unsigned, __builtin_convertvector(v, bf16x2_t)); }
__device__ __forceinline__ size_t a_tiled(size_t row, int col) { return ((size_t)(col >> 6) * M + row) * 64 + (col & 63); }
__device__ __forceinline__ size_t p_idx(size_t tok, int col) { return ((size_t)(col >> 7) * M + tok) * 128 + (col & 127); }
__device__ __forceinline__ float bf2f(unsigned short b) { return __builtin_bit_cast(float, ((unsigned)b) << 16); }
__device__ __forceinline__ float bflo(unsigned w) { return __builtin_bit_cast(float, w << 16); }
__device__ __forceinline__ float bfhi(unsigned w) { return __builtin_bit_cast(float, w & 0xffff0000u); }
__device__ __forceinline__ float sigmoidf_(float v) { return 1.0f / (1.0f + __expf(-v)); }
__device__ __forceinline__ float siluf_(float v) { return v / (1.0f + __expf(-v)); }


#define XB_TMO      128
#define XB_XCNT(j)  (256  + 64 * (j))
#define XB_XSUB(j)  (1280 + 64 * (j))
#define XB_XGEN(j)  (2304 + 64 * (j))
#define XB_TOP      3328
#define XB_TOPGEN   3392
#define XCD_BAR_WORDS 3456
#define XB_SPIN_CAP (1u << 18)

__device__ __forceinline__ unsigned xb_ld(unsigned* p)              { return __hip_atomic_load(p, __ATOMIC_RELAXED, __HIP_MEMORY_SCOPE_AGENT); }
__device__ __forceinline__ unsigned xb_add(unsigned* p, unsigned v) { return __hip_atomic_fetch_add(p, v, __ATOMIC_RELAXED, __HIP_MEMORY_SCOPE_AGENT); }
__device__ __forceinline__ unsigned xb_xcc_id() { return (unsigned)__builtin_amdgcn_s_getreg((3 << 11) | 20) & 0xFu; }
#define XB_SPIN(cond, bar) do { unsigned _sp = 0; while (cond) { __builtin_amdgcn_s_sleep(1); \
    if ((++_sp & 255u) == 0u) { if (xb_ld(&(bar)[XB_TMO])) break; if (_sp > XB_SPIN_CAP) { atomicAdd(&(bar)[XB_TMO], 1u); break; } } } } while (0)

struct XcdBarrier {
    unsigned* bar; unsigned x;
    volatile LAS unsigned* st;
};

__device__ __forceinline__ XcdBarrier xcd_barrier_post(unsigned* bar, volatile LAS unsigned* st) {
    XcdBarrier b; b.bar = bar; b.x = xb_xcc_id(); b.st = st;
    if (threadIdx.x == 0) (void)xb_add(&bar[XB_XCNT(b.x)], 1u);
    return b;
}
__device__ __forceinline__ void xcd_barrier_complete(unsigned* bar, unsigned x, unsigned& nloc, unsigned& nx) {
    const unsigned G = gridDim.x * gridDim.y * gridDim.z;
    unsigned sum, cnt, mine, sp = 0u;
    for (;;) {
        sum = 0u; cnt = 0u; mine = 0u;
#pragma unroll
        for (unsigned j = 0; j < 16; ++j) { const unsigned c = xb_ld(&bar[XB_XCNT(j)]); sum += c; cnt += (c > 0u) ? 1u : 0u; mine = (j == x) ? c : mine; }
        if (sum == G) break;
        __builtin_amdgcn_s_sleep(1);
        if ((++sp & 255u) == 0u) { if (xb_ld(&bar[XB_TMO])) break; if (sp > XB_SPIN_CAP) { atomicAdd(&bar[XB_TMO], 1u); break; } }
    }
    nloc = mine > 0u ? mine : 1u; nx = cnt > 0u ? cnt : 1u;
}

__device__ __forceinline__ void xcd_barrier(const XcdBarrier& b) {
    asm volatile("s_waitcnt vmcnt(0)" ::: "memory");
    __syncthreads();
    if (threadIdx.x == 0) {
        unsigned* bar = b.bar;
        __builtin_amdgcn_s_waitcnt(0);
        unsigned nloc = b.st[0], nx = b.st[1];
        if (nloc == 0u) { xcd_barrier_complete(bar, b.x, nloc, nx); b.st[0] = nloc; b.st[1] = nx; }
        const unsigned old = xb_add(&bar[XB_XSUB(b.x)], 1u);
        const unsigned gen = old / nloc;
        if (old + 1u == (gen + 1u) * nloc) {
            __builtin_amdgcn_fence(__ATOMIC_RELEASE, "agent");
            asm volatile("s_waitcnt vmcnt(0)" ::: "memory");
            const unsigned og = xb_add(&bar[XB_TOP], 1u);
            const unsigned tg = og / nx;
            if (og + 1u == (tg + 1u) * nx) xb_add(&bar[XB_TOPGEN], 1u);
            else XB_SPIN(xb_ld(&bar[XB_TOPGEN]) == tg, bar);
            __builtin_amdgcn_fence(__ATOMIC_ACQUIRE, "agent");
            xb_add(&bar[XB_XGEN(b.x)], 1u);
            asm volatile("s_waitcnt vmcnt(0)" ::: "memory");
        } else {
            XB_SPIN(xb_ld(&bar[XB_XGEN(b.x)]) == gen, bar);
            __builtin_amdgcn_fence(__ATOMIC_ACQUIRE, "agent");
            asm volatile("s_waitcnt vmcnt(0)" ::: "memory");
        }
    }
    __syncthreads();
}


struct Args { const float* in[18]; float* out; unsigned char* ws; int ph_lo, ph_hi, li, pad; };
typedef const __attribute__((address_space(4))) Args* KArgs;
struct Frame {
    LAS unsigned char* lds;
    volatile LAS unsigned* MISC;
    int tid, lane, wave;
    int vcu, G, cid;
};
#define F_x          (A->in[0])
#define F_c          (A->in[1])
#define F_norm_g     (A->in[2])
#define F_w_ada      (A->in[3])
#define F_b_ada      (A->in[4])
#define F_w_in       (A->in[5])
#define F_conv_w     (A->in[6])
#define F_conv_b     (A->in[7])
#define F_lru_wa     (A->in[8])
#define F_lru_ba     (A->in[9])
#define F_lru_wx     (A->in[10])
#define F_lru_bx     (A->in[11])
#define F_lru_lambda (A->in[12])
#define F_rpb        (A->in[13])
#define F_gn_lru     (A->in[14])
#define F_gn_att     (A->in[15])
#define F_w_out      (A->in[16])
#define F_final_g    (A->in[17])
#define F_out        (A->out)
#define F_ctl        ((gu32*)(A->ws + WS_CTL))
#define F_MOD        ((float*)(A->ws + WS_MOD))
#define F_WAT        ((bf16*)(A->ws + WS_WAT))
#define F_WXT        ((bf16*)(A->ws + WS_WXT))
#define F_WIN        ((bf16*)(A->ws + WS_WIN))
#define F_WOUT       ((bf16*)(A->ws + WS_WOUT))
#define F_HB         ((bf16*)(A->ws + WS_H))
#define F_PB         ((bf16*)(A->ws + WS_P))
#define F_YC         ((bf16*)(A->ws + WS_YC))
#define F_YB         ((bf16*)(A->ws + WS_YB))
#define F_LH         ((bf16*)(A->ws + WS_LH))
#define F_PF         ((bf16*)(A->ws + WS_PF))
#define F_PBK        ((bf16*)(A->ws + WS_PB))
#define F_SUM        ((float*)(A->ws + WS_SUM))
#define F_CAR        ((float*)(A->ws + WS_CAR))
#define F_SSQ        ((float*)(A->ws + WS_SSQ))
#define F_SSA        ((float*)(A->ws + WS_SSA))
#define F_SW         ((float*)(A->ws + WS_SW))
#define F_XB         ((bf16*)(A->ws + WS_XB))
#define F_RS         ((float*)(A->ws + WS_RS))

__device__ __forceinline__ float wave_sum(float v) {
#pragma unroll
    for (int o = 1; o < 64; o <<= 1) v += __shfl_xor(v, o);
    return v;
}


__device__ __forceinline__ int launder_v(int v) { asm volatile("" : "+v"(v)); return v; }
__device__ __forceinline__ float xor16_max(float x) { const auto s = __builtin_amdgcn_permlane16_swap(__builtin_bit_cast(unsigned, x), __builtin_bit_cast(unsigned, x), false, false);
    const unsigned s0 = s[0], s1 = s[1]; return fmaxf(__builtin_bit_cast(float, s0), __builtin_bit_cast(float, s1)); }
__device__ __forceinline__ float xor32_max(float x) { const auto s = __builtin_amdgcn_permlane32_swap(__builtin_bit_cast(unsigned, x), __builtin_bit_cast(unsigned, x), false, false);
    const unsigned s0 = s[0], s1 = s[1]; return fmaxf(__builtin_bit_cast(float, s0), __builtin_bit_cast(float, s1)); }
__device__ __forceinline__ float xor16_sum(float x) { const auto s = __builtin_amdgcn_permlane16_swap(__builtin_bit_cast(unsigned, x), __builtin_bit_cast(unsigned, x), false, false);
    const unsigned s0 = s[0], s1 = s[1]; return __builtin_bit_cast(float, s0) + __builtin_bit_cast(float, s1); }
__device__ __forceinline__ float xor32_sum(float x) { const auto s = __builtin_amdgcn_permlane32_swap(__builtin_bit_cast(unsigned, x), __builtin_bit_cast(unsigned, x), false, false);
    const unsigned s0 = s[0], s1 = s[1]; return __builtin_bit_cast(float, s0) + __builtin_bit_cast(float, s1); }

#ifndef P0_WIDE
#define P0_WIDE 0
#endif
__device__ __forceinline__ void p0_fetch(float (&rg)[32], const float* W, int N, int item, int lane) {
    const int nblk = N / 32, kb = item / nblk, nb = item % nblk, k0 = 64 * kb, n0 = 32 * nb;
#if P0_WIDE
    const float* p = W + (size_t)(k0 + (lane >> 3)) * N + n0 + 4 * (lane & 7);
#pragma unroll
    for (int i = 0; i < 8; ++i) { const f32x4 v = __builtin_nontemporal_load((const f32x4*)(p + (size_t)(8 * i) * N)); rg[4 * i] = v.x; rg[4 * i + 1] = v.y; rg[4 * i + 2] = v.z; rg[4 * i + 3] = v.w; }
#else
    const float* p = W + (size_t)(k0 + (lane >> 5)) * N + n0 + (lane & 31);
#pragma unroll
    for (int i = 0; i < 32; ++i) rg[i] = __builtin_nontemporal_load(p + (size_t)(2 * i) * N);
#endif
}
__device__ __forceinline__ void p0_stash(const float (&rg)[32], LAS float* scr, int lane) {
#if P0_WIDE
#pragma unroll
    for (int i = 0; i < 8; ++i) { LAS float* d = scr + (8 * i + (lane >> 3)) * 33 + 4 * (lane & 7); d[0] = rg[4 * i]; d[1] = rg[4 * i + 1]; d[2] = rg[4 * i + 2]; d[3] = rg[4 * i + 3]; }
#else
#pragma unroll
    for (int i = 0; i < 32; ++i) scr[(2 * i + (lane >> 5)) * 33 + (lane & 31)] = rg[i];
#endif
}
__device__ __forceinline__ void p0_transpose_load(const float* W, int N, LAS float* scr, int item, int lane) {
    float rg[32]; p0_fetch(rg, W, N, item, lane); p0_stash(rg, scr, lane);
}
template <bool TILED>
__device__ __forceinline__ void p0_transpose_store(int K, int N, bf16* WT, LAS float* scr, int item, int lane, int krot) {
    const int nblk = N / 32, kb = item / nblk, nb = item % nblk, k0 = 64 * kb, n0 = 32 * nb;
    const int c = lane & 7;
#pragma unroll
    for (int j = 0; j < 4; ++j) { const int n = (lane >> 3) + 8 * j; const LAS float* s = scr + (8 * c) * 33 + n;
        v4u o; o.x = pk2(s[0 * 33], s[1 * 33]); o.y = pk2(s[2 * 33], s[3 * 33]); o.z = pk2(s[4 * 33], s[5 * 33]); o.w = pk2(s[6 * 33], s[7 * 33]);
#ifdef WT_NT
        __builtin_nontemporal_store(o, (GAS v4u*)(WT + (TILED ? ((size_t)(((k0 + krot) & (K - 1)) >> 6) * N + n0 + n) * 64 : (size_t)(n0 + n) * K + ((k0 + krot) & (K - 1))) + 8 * c)); }
#else
        *(GAS v4u*)(WT + (TILED ? ((size_t)(((k0 + krot) & (K - 1)) >> 6) * N + n0 + n) * 64 : (size_t)(n0 + n) * K + ((k0 + krot) & (K - 1))) + 8 * c) = o; }
#endif
    LDS_WAIT(); asm volatile("" ::: "memory");
}
template <bool TILED>
__device__ __forceinline__ void p0_transpose_item(const float* W, int K, int N, bf16* WT, LAS float* scr, int item, int lane, int krot = 0) {
    p0_transpose_load(W, N, scr, item, lane);
    LDS_WAIT(); asm volatile("" ::: "memory");
    p0_transpose_store<TILED>(K, N, WT, scr, item, lane, krot);
}

__device__ __forceinline__ void p0_mod_phase(Frame& F0, KArgs A0) {
    Frame F = F0; { const int t_ = launder_v((int)threadIdx.x); F.tid = t_; F.lane = t_ & 63; F.wave = __builtin_amdgcn_readfirstlane(t_ >> 6); }
    KArgs A = A0; asm volatile("" : "+s"(A));
    {
        __syncthreads();
        LAS float* cond = (LAS float*)(F.lds + RING_OFF);
        LAS float* red = (LAS float*)(F.lds + RING_OFF + 32768);
        for (int i = F.tid; i < 2 * D; i += NWAVES * 64) { const float v = F_c[i]; cond[i] = siluf_(v); }
        __syncthreads();
        const int c4 = F.lane & 31, half = F.lane >> 5; const bool act = c4 < 24;
        for (int it = blockIdx.x; it < DEPTH * 128; it += F.G) {
            const int l = it >> 7, cg = it & 127;
            const float* W = F_w_ada + (size_t)l * D * (3 * D) + cg * 96 + 4 * (act ? c4 : 0);
            const int kbase = F.wave * 512 + half;
            f32x4 a0 = {0.f, 0.f, 0.f, 0.f}, a1 = {0.f, 0.f, 0.f, 0.f};
            if (act) {
#pragma unroll 8
                for (int i = 0; i < 256; ++i) { const int k = kbase + 2 * i;
                    const f32x4 w = __builtin_nontemporal_load((const f32x4*)(W + (size_t)k * (3 * D)));
                    const float s0 = cond[k], s1 = cond[D + k]; a0 += w * s0; a1 += w * s1; }
            }
#pragma unroll
            for (int j = 0; j < 4; ++j) { a0[j] += __shfl_xor(a0[j], 32); a1[j] += __shfl_xor(a1[j], 32); }
            if (half == 0 && act) {
#pragma unroll
                for (int j = 0; j < 4; ++j) { red[(F.wave * 2 + 0) * 96 + 4 * c4 + j] = a0[j]; red[(F.wave * 2 + 1) * 96 + 4 * c4 + j] = a1[j]; } }
            __syncthreads();
            if (F.tid < 192) { const int b = F.tid / 96, cc = F.tid % 96; float s = 0.f;
#pragma unroll
                for (int w = 0; w < 8; ++w) s += red[(w * 2 + b) * 96 + cc];
                F_MOD[(size_t)(l * 2 + b) * (3 * D) + cg * 96 + cc] = s + F_b_ada[(size_t)l * (3 * D) + cg * 96 + cc]; }
            __syncthreads();
        }
    }
}

__device__ __forceinline__ void p0_convert_phase(Frame& F0, KArgs A0) {
    Frame F = F0; { const int t_ = launder_v((int)threadIdx.x); F.tid = t_; F.lane = t_ & 63; F.wave = __builtin_amdgcn_readfirstlane(t_ >> 6); }
    KArgs A = A0; asm volatile("" : "+s"(A));
    LAS float* scr = (LAS float*)(F.lds + RING_OFF + F.wave * 16384);
    LAS float* shv = scr + 64 * 33;
    const int gw = F.vcu * NWAVES + F.wave;
    constexpr int NB_IN = DIN / 32, N_BIG = DEPTH * NB_IN;
    constexpr int I_OUT = (D / 64) * (D / 32), I_G = 8, N_OUT = DEPTH * I_OUT, N_G = DEPTH * 2 * NBLK * I_G;
    if (gw < N_BIG) {
        const int l = gw / NB_IN, nb = gw % NB_IN, n = F.lane & 31, b = F.lane >> 5;
        const float* W = F_w_in + (size_t)l * D * DIN; bf16* WT = F_WIN + (size_t)l * DIN * D;
        float acc = 0.f;
        for (int kb = 0; kb < D / 64; ++kb) {
            const float s0 = F_MOD[(size_t)(l * 2 + 0) * (3 * D) + 64 * kb + F.lane], s1 = F_MOD[(size_t)(l * 2 + 1) * (3 * D) + 64 * kb + F.lane];
            p0_transpose_load(W, DIN, scr, kb * NB_IN + nb, F.lane);
            shv[F.lane] = s0; shv[64 + F.lane] = s1;
            LDS_WAIT(); asm volatile("" ::: "memory");
#pragma unroll 16
            for (int kk = 0; kk < 64; ++kk) acc = __builtin_fmaf(shv[b * 64 + kk], scr[kk * 33 + n], acc);
            p0_transpose_store<true>(D, DIN, WT, scr, kb * NB_IN + nb, F.lane, 0);
        }
        F_SW[(size_t)(l * 2 + b) * DIN + 32 * nb + n] = acc;
    } else {
        for (int it = gw - N_BIG; it < N_OUT + 2 * N_G; it += F.G * NWAVES - N_BIG) {
            int r = it;
            if (r < N_OUT) { const int l = r / I_OUT; p0_transpose_item<true>(F_w_out + (size_t)l * D * D, D, D, F_WOUT + (size_t)l * D * D, scr, r % I_OUT, F.lane, WL); continue; } r -= N_OUT;
            if (r < N_G) { const int mt = r / I_G; p0_transpose_item<false>(F_lru_wa + (size_t)mt * BW * BW, BW, BW, F_WAT + (size_t)mt * BW * BW, scr, r % I_G, F.lane); continue; } r -= N_G;
            { const int mt = r / I_G; p0_transpose_item<false>(F_lru_wx + (size_t)mt * BW * BW, BW, BW, F_WXT + (size_t)mt * BW * BW, scr, r % I_G, F.lane); }
        }
    }
}

__device__ __forceinline__ void norm0_phase(Frame& F0, KArgs A0, const float* x, int l) {
    Frame F = F0; { const int t_ = launder_v((int)threadIdx.x); F.tid = t_; F.lane = t_ & 63; F.wave = __builtin_amdgcn_readfirstlane(t_ >> 6); }
    KArgs A = A0; asm volatile("" : "+s"(A));
    const int gw = F.vcu * NWAVES + F.wave, NGW = F.G * NWAVES;
    const float* g = F_norm_g + (size_t)l * D;
    for (int m = gw; m < M; m += NGW) {
        const float* modp = F_MOD + (size_t)(l * 2 + (m >> 12)) * (3 * D);
        const GAS f32x4* xr = (const GAS f32x4*)(x + (size_t)m * D) + F.lane;
        f32x4 v[16]; float s = 0.f;
#pragma unroll
        for (int j = 0; j < 16; ++j) { v[j] = xr[64 * j]; s += (v[j].x * v[j].x + v[j].y * v[j].y) + (v[j].z * v[j].z + v[j].w * v[j].w); }
        s = wave_sum(s);
        F_RS[(size_t)m * 64 + F.lane] = (F.lane == 0) ? s : 0.f;
        bf16* hb = F_HB;
#pragma unroll
        for (int j = 0; j < 16; ++j) { const int col = 4 * F.lane + 256 * j;
            const f32x4 g4 = *(const f32x4*)(g + col), sc = *(const f32x4*)(modp + D + col);
            const f32x4 o = v[j] * g4 * (sc + 1.0f);
            v2u w; w.x = pk2(o.x, o.y); w.y = pk2(o.z, o.w); *(GAS v2u*)(hb + a_tiled((size_t)m, col)) = w; }
    }
}

__device__ __forceinline__ void final_norm_phase(Frame& F0, KArgs A0, float* x) {
    Frame F = F0; { const int t_ = launder_v((int)threadIdx.x); F.tid = t_; F.lane = t_ & 63; F.wave = __builtin_amdgcn_readfirstlane(t_ >> 6); }
    KArgs A = A0; asm volatile("" : "+s"(A));
    const int gw = F.vcu * NWAVES + F.wave, NGW = F.G * NWAVES;
    for (int m = gw; m < M; m += NGW) {
        GAS f32x4* xr = (GAS f32x4*)(x + (size_t)m * D) + F.lane;
        f32x4 v[16]; float s = 0.f;
#pragma unroll
        for (int j = 0; j < 16; ++j) { v[j] = xr[64 * j]; s += (v[j].x * v[j].x + v[j].y * v[j].y) + (v[j].z * v[j].z + v[j].w * v[j].w); }
        const float rstd = 1.0f / sqrtf(wave_sum(s) * (1.f / D) + EPS);
#pragma unroll
        for (int j = 0; j < 16; ++j) { const f32x4 g4 = *(const f32x4*)(F_final_g + 4 * F.lane + 256 * j); xr[64 * j] = (v[j] * rstd) * g4; }
    }
}

typedef float f32x16 __attribute__((ext_vector_type(16)));
constexpr int X16P = 136;
constexpr int LRU_X32 = 0, LRU_X16 = TC * BW * 4, LRU_RES = LRU_X16 + TC * X16P * 2, LRU_END = LRU_RES + 2 * TC * BW * 4;
static_assert(LRU_END <= RING_BYTES && (LRU_X16 % 16) == 0 && (LRU_RES % 16) == 0, "LRU LDS map");
constexpr float LOG2E = 1.4426950408889634f;

template <int E>
__device__ __forceinline__ void lru_tile(const f32x16& accR, const f32x16& accI, const LAS float* xrow, LAS unsigned* rrow, int h, float bR, float bI, float c1, float& Hc, float& Pc) {
    float a[16], bb[16];
    typedef float f2 __attribute__((ext_vector_type(2)));
    const float nbR = -LOG2E * bR, nbI = -LOG2E * bI;
#pragma unroll
    for (int rp = 0; rp < 8; ++rp) {
        const int r0 = 2 * rp, r1 = r0 + 1;
        const f2 xc = {xrow[((r0 & 3) + 8 * (r0 >> 2)) * BW], xrow[((r1 & 3) + 8 * (r1 >> 2)) * BW]};
        const f2 er = (f2){accR[r0], accR[r1]} * (-LOG2E) + nbR, ei = (f2){accI[r0], accI[r1]} * (-LOG2E) + nbI;
        const f2 dr = (f2){__builtin_amdgcn_exp2f(er.x), __builtin_amdgcn_exp2f(er.y)} + 1.0f, di = (f2){__builtin_amdgcn_exp2f(ei.x), __builtin_amdgcn_exp2f(ei.y)} + 1.0f;
        const f2 r = {__builtin_amdgcn_rcpf(dr.x), __builtin_amdgcn_rcpf(dr.y)}, ig = {__builtin_amdgcn_rcpf(di.x), __builtin_amdgcn_rcpf(di.y)};
        const f2 ca = r * c1;
        const f2 av = {__builtin_amdgcn_exp2f(ca.x), __builtin_amdgcn_exp2f(ca.y)};
        const f2 om = 1.0f - av * av;
        const f2 sq = {__builtin_amdgcn_sqrtf(om.x), __builtin_amdgcn_sqrtf(om.y)};
        const f2 bv = sq * (ig * xc);
        a[r0] = av.x; a[r1] = av.y; bb[r0] = bv.x; bb[r1] = bv.y;
    }
    float lcl[16], p[16], As[4], Bs[4], Ao[4], Bo[4];
#pragma unroll
    for (int g = 0; g < 4; ++g) {
        if (E == 0) {
            lcl[4 * g] = bb[4 * g]; p[4 * g] = a[4 * g];
#pragma unroll
            for (int i = 1; i < 4; ++i) { lcl[4 * g + i] = __builtin_fmaf(a[4 * g + i], lcl[4 * g + i - 1], bb[4 * g + i]); p[4 * g + i] = a[4 * g + i] * p[4 * g + i - 1]; }
            As[g] = p[4 * g + 3]; Bs[g] = lcl[4 * g + 3];
        } else {
            lcl[4 * g + 3] = bb[4 * g + 3]; p[4 * g + 3] = a[4 * g + 3];
#pragma unroll
            for (int i = 2; i >= 0; --i) { lcl[4 * g + i] = __builtin_fmaf(a[4 * g + i], lcl[4 * g + i + 1], bb[4 * g + i]); p[4 * g + i] = a[4 * g + i] * p[4 * g + i + 1]; }
            As[g] = p[4 * g]; Bs[g] = lcl[4 * g];
        }
        { const auto ta = __builtin_amdgcn_permlane32_swap(__builtin_bit_cast(unsigned, As[g]), __builtin_bit_cast(unsigned, As[g]), false, false);
          const auto tb = __builtin_amdgcn_permlane32_swap(__builtin_bit_cast(unsigned, Bs[g]), __builtin_bit_cast(unsigned, Bs[g]), false, false);
          const unsigned a0_ = ta[0], a1_ = ta[1], b0_ = tb[0], b1_ = tb[1];
          As[g] = __builtin_bit_cast(float, a0_); Ao[g] = __builtin_bit_cast(float, a1_); Bs[g] = __builtin_bit_cast(float, b0_); Bo[g] = __builtin_bit_cast(float, b1_); }
    }
    float cinH[4], cinP[4];
#pragma unroll
    for (int gg = 0; gg < 4; ++gg) {
        const int g = (E == 0) ? gg : (3 - gg);
        const float A0 = As[g], B0 = Bs[g];
        const float A1 = Ao[g], B1 = Bo[g];
        float H0, P0, H1, P1;
        if (E == 0) { H0 = Hc; P0 = Pc; Hc = __builtin_fmaf(A0, Hc, B0); Pc *= A0; H1 = Hc; P1 = Pc; Hc = __builtin_fmaf(A1, Hc, B1); Pc *= A1; }
        else        { H1 = Hc; P1 = Pc; Hc = __builtin_fmaf(A1, Hc, B1); Pc *= A1; H0 = Hc; P0 = Pc; Hc = __builtin_fmaf(A0, Hc, B0); Pc *= A0; }
        cinH[g] = h ? H1 : H0; cinP[g] = h ? P1 : P0;
    }
#pragma unroll
    for (int reg = 0; reg < 16; ++reg) {
        const float lh = __builtin_fmaf(p[reg], cinH[reg >> 2], lcl[reg]), pv = p[reg] * cinP[reg >> 2];
        rrow[((reg & 3) + 8 * (reg >> 2)) * BW] = pk2(lh, pv);
    }
}

__device__ __forceinline__ void lru_local_phase(Frame& F0, KArgs A0, int l) {
    Frame F = F0; { const int t_ = launder_v((int)threadIdx.x); F.tid = t_; F.lane = t_ & 63; F.wave = __builtin_amdgcn_readfirstlane(t_ >> 6); }
    KArgs A = A0; asm volatile("" : "+s"(A));
    LAS float* X32 = (LAS float*)(F.lds + RING_OFF + LRU_X32);
    LAS unsigned char* X16 = F.lds + RING_OFF + LRU_X16;
    LAS unsigned* RES = (LAS unsigned*)(F.lds + RING_OFF + LRU_RES);
    const int tid = F.tid, lane = F.lane;
    const int e = F.wave & 1, cb = F.wave >> 1, jl = lane & 31, h = lane >> 5;
    const int ch4 = tid & 31, tq = tid >> 5;
    bf16x8 WR[8], WI[8]; float bR = 0.f, bI = 0.f, c1 = 0.f; int last_n = -1;
#define LRU_LOAD_ROWS(dst, uu) do { const int n_ = (uu) & (NBLK - 1), pc_ = (uu) >> 4, b_ = pc_ / NCH, t0_ = (pc_ % NCH) * TC; \
        const bf16* xa_ = F_PB + p_idx((size_t)(b_ * SEQ), OFF_XA + n_ * BW) + 4 * ch4; \
        _Pragma("unroll") for (int i_ = 0; i_ < 7; ++i_) { const int t_ = t0_ + 4 * tq - 2 + i_; const int tc_ = min(max(t_, 0), SEQ - 1); \
            v2u w_ = *(const v2u*)(xa_ + (size_t)tc_ * 128); if (t_ != tc_) { w_.x = 0u; w_.y = 0u; } (dst)[i_] = w_; } } while (0)
    v2u rwn[7];
    if (F.cid < BATCH * NCH * NBLK) LRU_LOAD_ROWS(rwn, F.cid);
    for (int u = F.cid; u < BATCH * NCH * NBLK; u += F.G) {
        const int n = u & (NBLK - 1), pc = u >> 4, b = pc / NCH, cidx = pc % NCH, t0 = cidx * TC;
        if (n != last_n) {
            last_n = n;
            const bf16* wr = F_WAT + ((size_t)((l * 2 + e) * NBLK + n) * BW + 32 * cb + jl) * BW + 8 * h;
            const bf16* wi = F_WXT + ((size_t)((l * 2 + e) * NBLK + n) * BW + 32 * cb + jl) * BW + 8 * h;
#pragma unroll
            for (int s = 0; s < 8; ++s) { WR[s] = *(const bf16x8*)(wr + 16 * s); WI[s] = *(const bf16x8*)(wi + 16 * s); }
            const int ch = n * BW + 32 * cb + jl;
            bR = F_lru_ba[(size_t)(l * 2 + e) * WL + ch]; bI = F_lru_bx[(size_t)(l * 2 + e) * WL + ch];
            c1 = -C_RG * LOG2E * log1pf(expf(-F_lru_lambda[(size_t)(l * 2 + e) * WL + ch]));
        }
        {
            f32x4 rw[7];
#pragma unroll
            for (int i = 0; i < 7; ++i) rw[i] = (f32x4){bflo(rwn[i].x), bfhi(rwn[i].x), bflo(rwn[i].y), bfhi(rwn[i].y)};
            const float* cwp = F_conv_w + (size_t)l * 4 * WL + n * BW + 4 * ch4;
            const f32x4 w0 = *(const f32x4*)(cwp), w1 = *(const f32x4*)(cwp + WL), w2 = *(const f32x4*)(cwp + 2 * WL), w3 = *(const f32x4*)(cwp + 3 * WL);
            const f32x4 cbv = *(const f32x4*)(F_conv_b + (size_t)l * WL + n * BW + 4 * ch4);
#pragma unroll
            for (int i = 0; i < 4; ++i) { const f32x4 xc = cbv + w0 * rw[i] + w1 * rw[i + 1] + w2 * rw[i + 2] + w3 * rw[i + 3];
                const int t = 4 * tq + i;
                *(LAS f32x4*)(X32 + t * BW + 4 * ch4) = xc;
                v2u w; w.x = pk2(xc.x, xc.y); w.y = pk2(xc.z, xc.w); *(LAS v2u*)(X16 + (t * X16P + 4 * ch4) * 2) = w; }
        }
        if (u + F.G < BATCH * NCH * NBLK) LRU_LOAD_ROWS(rwn, u + F.G);
        __syncthreads();
        {
            float Hc = 0.f, Pc = 1.f;
#pragma unroll
            for (int tt = 0; tt < TC / 32; ++tt) {
                const int tile = e ? (TC / 32 - 1 - tt) : tt;
                bf16x8 Af[8];
                const LAS unsigned char* ap = X16 + ((32 * tile + jl) * X16P + 8 * h) * 2;
#pragma unroll
                for (int s = 0; s < 8; ++s) Af[s] = *(const LAS bf16x8*)(ap + 32 * s);
                f32x16 accR, accI;
#pragma unroll
                for (int i = 0; i < 16; ++i) { accR[i] = 0.f; accI[i] = 0.f; }
#pragma unroll
                for (int s = 0; s < 8; ++s) { accR = __builtin_amdgcn_mfma_f32_32x32x16_bf16(Af[s], WR[s], accR, 0, 0, 0); accI = __builtin_amdgcn_mfma_f32_32x32x16_bf16(Af[s], WI[s], accI, 0, 0, 0); }
                const LAS float* xrow = X32 + (32 * tile + 4 * h) * BW + 32 * cb + jl;
                LAS unsigned* rrow = RES + (e * TC + 32 * tile + 4 * h) * BW + 32 * cb + jl;
                if (e == 0) lru_tile<0>(accR, accI, xrow, rrow, h, bR, bI, c1, Hc, Pc); else lru_tile<1>(accR, accI, xrow, rrow, h, bR, bI, c1, Hc, Pc);
            }
            if (h == 0) { gu64* sp = (gu64*)(F_SUM + ((size_t)((b * NCH + cidx) * 2 + e) * WL + n * BW + 32 * cb + jl) * 2);
                __hip_atomic_store(sp, ((unsigned long long)__builtin_bit_cast(unsigned, Hc) << 32) | __builtin_bit_cast(unsigned, Pc), RLX_AGENT); }
        }
        __syncthreads();
        {
#pragma unroll
            for (int i = 0; i < 4; ++i) { const int t = 4 * tq + i;
                const v4u f = *(const LAS v4u*)(RES + t * BW + 4 * ch4), k = *(const LAS v4u*)(RES + (TC + t) * BW + 4 * ch4);
                v2u lh, pf, pb;
                lh.x = pk2(bflo(f.x) + bflo(k.x), bflo(f.y) + bflo(k.y)); lh.y = pk2(bflo(f.z) + bflo(k.z), bflo(f.w) + bflo(k.w));
                pf.x = (f.x >> 16) | (f.y & 0xffff0000u); pf.y = (f.z >> 16) | (f.w & 0xffff0000u);
                pb.x = (k.x >> 16) | (k.y & 0xffff0000u); pb.y = (k.z >> 16) | (k.w & 0xffff0000u);
                const size_t o = ((size_t)((b * NCH + cidx) * NBLK + n) * TC + t) * BW + 4 * ch4;
                *(v2u*)(F_LH + o) = lh; *(v2u*)(F_PF + o) = pf; *(v2u*)(F_PBK + o) = pb; }
        }
    }
#undef LRU_LOAD_ROWS
    {
        const int n = F.cid & (NBLK - 1);
        LAS unsigned* flg = (LAS unsigned*)(F.lds + RING_OFF + LRU_END);
        asm volatile("s_waitcnt vmcnt(0)" ::: "memory");
        __syncthreads();
        if (tid == 0) { const unsigned old = __hip_atomic_fetch_add((unsigned*)(F_ctl + CW_CARRY + 16 * (16 * l + n)), 1u, __ATOMIC_RELAXED, __HIP_MEMORY_SCOPE_AGENT);
            if (old == (unsigned)(F.G / NBLK) - 1u) { __builtin_amdgcn_fence(__ATOMIC_ACQUIRE, "agent"); asm volatile("s_waitcnt vmcnt(0)" ::: "memory"); }
            flg[0] = (old == (unsigned)(F.G / NBLK) - 1u) ? 1u : 0u; }
        __syncthreads();
        if (flg[0] != 0u) {
            const int bb = tid >> 8, ee = (tid >> 7) & 1, ch = n * BW + (tid & 127);
            float cin = 0.f;
#ifndef CHB
#define CHB 32
#endif
#pragma unroll 1
            for (int s0 = 0; s0 < NCH; s0 += CHB) {
                unsigned long long sw_[CHB];
#pragma unroll
                for (int s = 0; s < CHB; ++s) { const int ci = ee ? (NCH - 1 - (s0 + s)) : (s0 + s);
                    sw_[s] = __hip_atomic_load((gu64*)(F_SUM + ((size_t)((bb * NCH + ci) * 2 + ee) * WL + ch) * 2), RLX_AGENT); }
#pragma unroll
                for (int s = 0; s < CHB; ++s) { const int ci = ee ? (NCH - 1 - (s0 + s)) : (s0 + s);
                    const size_t o = (size_t)((bb * NCH + ci) * 2 + ee) * WL + ch;
                    __hip_atomic_store((gu32*)(F_CAR + o), __builtin_bit_cast(unsigned, cin), RLX_AGENT);
                    cin = __builtin_fmaf(__builtin_bit_cast(float, (unsigned)sw_[s]), cin, __builtin_bit_cast(float, (unsigned)(sw_[s] >> 32))); }
            }
            asm volatile("s_waitcnt vmcnt(0)" ::: "memory");
            __syncthreads();
            if (tid == 0) __hip_atomic_store((gu32*)(F_ctl + CW_CREADY + 16 * (16 * l + n)), 1u, RLX_AGENT);
        }
        __syncthreads();
    }
}

typedef short s16x4 __attribute__((ext_vector_type(4)));
typedef LAS s16x4 lds_s16x4;
constexpr int ATT_SLOT = 32768;
constexpr int ATT_NSLOT = 4;
constexpr int ATT_BTAB = ATT_NSLOT * ATT_SLOT;
static_assert(ATT_BTAB + 2048 <= PHASE_LDS, "attention LDS map");

template <int DLT>
__device__ __forceinline__ void attn_pair_task(KArgs A, int l, int b, int h, int j4, int wave, int lane, LAS unsigned char* ring, const LAS float* btab) {
    constexpr int NU = 8 + DLT;
    const int q = lane & 15, g = lane >> 4, pr = wave >> 2, qt = wave & 3;
    const float SCL2 = 0.08838834764831845f * LOG2E;
    const int rA = 4 * j4 + 2 * pr, rB = rA + 1;
    const int kr0 = min(max(4 * j4 - 4, 0), ROWS - KR);
    const int rs = min(max(rA - 4, 0), ROWS - KR);
    const int PRE = rs - kr0, NS = min(max(4 * j4 - 2, 0), ROWS - KR) + NU - kr0;
    const int c0 = 16 * qt, kb = min(max(c0 - 8, 0), 32), xb = (kb >> 3) & 1;
    const int c = c0 + q, cs = min(max(c - 8, 0), GW - KC);
    const char* ksrc = (const char*)(F_PB + p_idx((size_t)(b * SEQ + kr0 * GW), OFF_K + h * HD)) + 2048 * wave;
    const char* vsrc = (const char*)(F_PB + p_idx((size_t)(b * SEQ + kr0 * GW), OFF_V + h * HD)) + 2048 * wave;
    LAS unsigned char* dstw = ring + 2048 * wave;
    const unsigned lofs0 = (unsigned)(g * 128) * 2u + 16u * (unsigned)(q ^ ((g << 2) | ((2 * wave) & 3)));
    const unsigned lofs1 = (unsigned)(g * 128) * 2u + 16u * (unsigned)(q ^ ((g << 2) | ((2 * wave + 1) & 3)));
#define ROW_DMA(s_) do { const int s2_ = (s_), r2_ = min(s2_, NS - 1);     \
        const char* kp_ = ksrc + (size_t)r2_ * (GW * 256); const char* vp_ = vsrc + (size_t)r2_ * (GW * 256); LAS unsigned char* d_ = dstw + (s2_ & (ATT_NSLOT - 1)) * ATT_SLOT; \
        asm volatile("" : "+s"(kp_), "+s"(vp_));                     \
        __builtin_amdgcn_global_load_lds((const unsigned*)(kp_ + lofs0), (LAS unsigned*)(d_), 16, 0, 0); \
        __builtin_amdgcn_global_load_lds((const unsigned*)(kp_ + 1024 + lofs1), (LAS unsigned*)(d_ + 1024), 16, 0, 0); \
        __builtin_amdgcn_global_load_lds((const unsigned*)(vp_ + lofs0), (LAS unsigned*)(d_ + 16384), 16, 0, 0); \
        __builtin_amdgcn_global_load_lds((const unsigned*)(vp_ + 1024 + lofs1), (LAS unsigned*)(d_ + 16384 + 1024), 16, 0, 0); } while (0)
#define ROW_SYNC(s_) do { const int s1_ = (s_); asm volatile("s_waitcnt vmcnt(8)" ::: "memory"); __builtin_amdgcn_s_barrier(); asm volatile("" ::: "memory"); ROW_DMA(s1_ + 3); } while (0)
    bf16x8 QA[4], QB[4];
    { const bf16* qp = F_PB + p_idx((size_t)(b * SEQ + rA * GW + c), OFF_Q + h * HD) + 8 * g;
#pragma unroll
      for (int s = 0; s < 4; ++s) { QA[s] = *(const bf16x8*)(qp + 32 * s); QB[s] = *(const bf16x8*)(qp + (size_t)GW * 128 + 32 * s); } }
    asm volatile("s_waitcnt vmcnt(0)" : "+v"(QA[0]), "+v"(QA[1]), "+v"(QA[2]), "+v"(QA[3]), "+v"(QB[0]), "+v"(QB[1]), "+v"(QB[2]), "+v"(QB[3]) :: "memory");
    ROW_DMA(0); ROW_DMA(1); ROW_DMA(2);
    const unsigned ringa = (unsigned)(size_t)ring;
    const unsigned kf0 = ringa + 256u * (unsigned)(kb + 8 * (q >> 2) + (q & 3)) + 16u * (unsigned)(g ^ (2 * xb) ^ ((2 * (q >> 2)) & 3));
    const unsigned kf1 = ringa + 256u * (unsigned)(kb + 8 * (q >> 2) + 4 + (q & 3)) + 16u * (unsigned)(g ^ (2 * xb) ^ ((2 * (q >> 2) + 1) & 3));
    const unsigned kx = 64u * (unsigned)(q & 3);
    const unsigned tqq = (unsigned)(q >> 2), tp = (unsigned)(q & 3);
    const unsigned tr0 = ringa + 16384u + 256u * (unsigned)(kb + 8 * g) + 256u * tqq + 32u * ((tqq << 1) | (unsigned)((g & 1) ^ xb)) + 16u * (tp >> 1) + 8u * (tp & 1);
    const unsigned tr1 = ringa + 16384u + 256u * (unsigned)(kb + 8 * g + 4) + 256u * tqq + 32u * ((tqq << 1) | (unsigned)((g & 1) ^ xb)) + 16u * ((tp >> 1) ^ 1u) + 8u * (tp & 1);
    const int dv = kb + 8 * g - cs;
    const LAS float* btA = btab + 8 + (rs - rA + (KR - 1)) * (2 * KC - 1) + (kb + 8 * g - c + (KC - 1));
    const LAS float* btB = btA - (2 * KC - 1);
    float mA = -INFINITY, mB = -INFINITY, lA = 0.f, lB = 0.f;
    f32x4 oA[8], oB[8];
#pragma unroll
    for (int c4 = 0; c4 < 8; ++c4) { oA[c4] = (f32x4){0.f, 0.f, 0.f, 0.f}; oB[c4] = (f32x4){0.f, 0.f, 0.f, 0.f}; }
    for (int s = 0; s < PRE; ++s) ROW_SYNC(s);
#pragma unroll
    for (int u = 0; u < NU; ++u) {
        ROW_SYNC(PRE + u);
        unsigned sb = (unsigned)((PRE + u) & (ATT_NSLOT - 1)) * (unsigned)ATT_SLOT;
        asm volatile("" : "+s"(sb));
        float bsA[8], bsB[8];
#pragma unroll
        for (int j = 0; j < 8; ++j) { bsA[j] = (u < 8) ? btA[(2 * KC - 1) * u + j] : 0.f; bsB[j] = (u >= DLT) ? btB[(2 * KC - 1) * u + j] : 0.f; }
        f32x4 a0 = {0.f, 0.f, 0.f, 0.f}, a1 = {0.f, 0.f, 0.f, 0.f}, b0 = {0.f, 0.f, 0.f, 0.f}, b1 = {0.f, 0.f, 0.f, 0.f};
#pragma unroll
        for (int s = 0; s < 4; ++s) {
            const bf16x8 k0 = *(const LAS bf16x8*)(size_t)(kf0 + sb + ((64u * s) ^ kx)), k1 = *(const LAS bf16x8*)(size_t)(kf1 + sb + ((64u * s) ^ kx));
            if (u < 8) { a0 = __builtin_amdgcn_mfma_f32_16x16x32_bf16(k0, QA[s], a0, 0, 0, 0); a1 = __builtin_amdgcn_mfma_f32_16x16x32_bf16(k1, QA[s], a1, 0, 0, 0); }
            if (u >= DLT) { b0 = __builtin_amdgcn_mfma_f32_16x16x32_bf16(k0, QB[s], b0, 0, 0, 0); b1 = __builtin_amdgcn_mfma_f32_16x16x32_bf16(k1, QB[s], b1, 0, 0, 0); } }
        asm volatile("s_waitcnt lgkmcnt(0)" : "+v"(bsA[0]), "+v"(bsA[1]), "+v"(bsA[2]), "+v"(bsA[3]), "+v"(bsA[4]), "+v"(bsA[5]), "+v"(bsA[6]), "+v"(bsA[7]),
                                             "+v"(bsB[0]), "+v"(bsB[1]), "+v"(bsB[2]), "+v"(bsB[3]), "+v"(bsB[4]), "+v"(bsB[5]), "+v"(bsB[6]), "+v"(bsB[7]) :: "memory");
        bf16x8 PA, PB_;
        if (u < 8) {
            float v[8], rm = -INFINITY;
#pragma unroll
            for (int j = 0; j < 8; ++j) { const float t_ = __builtin_fmaf(j < 4 ? a0[j & 3] : a1[j & 3], SCL2, bsA[j]); v[j] = ((unsigned)(dv + j) < (unsigned)KC) ? t_ : -INFINITY; rm = fmaxf(rm, v[j]); }
            rm = xor32_max(xor16_max(rm));
            const float mn = fmaxf(mA, rm), al = __builtin_amdgcn_exp2f(mA - mn); mA = mn;
            float ps = 0.f;
#pragma unroll
            for (int j = 0; j < 8; ++j) { v[j] = __builtin_amdgcn_exp2f(v[j] - mn); ps += v[j]; }
            lA = __builtin_fmaf(lA, al, ps); asm volatile("" : "+v"(lA));
#pragma unroll
            for (int c4 = 0; c4 < 8; ++c4) oA[c4] *= al;
            v4u w; w.x = pk2(v[0], v[1]); w.y = pk2(v[2], v[3]); w.z = pk2(v[4], v[5]); w.w = pk2(v[6], v[7]); PA = __builtin_bit_cast(bf16x8, w);
        }
        if (u >= DLT) {
            float v[8], rm = -INFINITY;
#pragma unroll
            for (int j = 0; j < 8; ++j) { const float t_ = __builtin_fmaf(j < 4 ? b0[j & 3] : b1[j & 3], SCL2, bsB[j]); v[j] = ((unsigned)(dv + j) < (unsigned)KC) ? t_ : -INFINITY; rm = fmaxf(rm, v[j]); }
            rm = xor32_max(xor16_max(rm));
            const float mn = fmaxf(mB, rm), al = __builtin_amdgcn_exp2f(mB - mn); mB = mn;
            float ps = 0.f;
#pragma unroll
            for (int j = 0; j < 8; ++j) { v[j] = __builtin_amdgcn_exp2f(v[j] - mn); ps += v[j]; }
            lB = __builtin_fmaf(lB, al, ps); asm volatile("" : "+v"(lB));
#pragma unroll
            for (int c4 = 0; c4 < 8; ++c4) oB[c4] *= al;
            v4u w; w.x = pk2(v[0], v[1]); w.y = pk2(v[2], v[3]); w.z = pk2(v[4], v[5]); w.w = pk2(v[6], v[7]); PB_ = __builtin_bit_cast(bf16x8, w);
        }
        asm volatile("s_waitcnt lgkmcnt(0)" ::: "memory");
        {
            const unsigned t0 = tr0 + sb, t1 = tr1 + sb;
            s16x4 lo[8], hi[8];
#define TR8(dst, base) asm volatile("ds_read_b64_tr_b16 %0, %8\n\tds_read_b64_tr_b16 %1, %9\n\tds_read_b64_tr_b16 %2, %10\n\tds_read_b64_tr_b16 %3, %11\n\t" \
                "ds_read_b64_tr_b16 %4, %12\n\tds_read_b64_tr_b16 %5, %13\n\tds_read_b64_tr_b16 %6, %14\n\tds_read_b64_tr_b16 %7, %15\n\ts_waitcnt lgkmcnt(0)" \
                : "=&v"((dst)[0]), "=&v"((dst)[1]), "=&v"((dst)[2]), "=&v"((dst)[3]), "=&v"((dst)[4]), "=&v"((dst)[5]), "=&v"((dst)[6]), "=&v"((dst)[7]) \
                : "v"((base) ^ 0u), "v"((base) ^ 32u), "v"((base) ^ 64u), "v"((base) ^ 96u), "v"((base) ^ 128u), "v"((base) ^ 160u), "v"((base) ^ 192u), "v"((base) ^ 224u) : "memory")
            TR8(lo, t0); TR8(hi, t1);
#undef TR8
#pragma unroll
            for (int c4 = 0; c4 < 8; ++c4) { const bf16x8 vf = __builtin_shufflevector(lo[c4], hi[c4], 0, 1, 2, 3, 4, 5, 6, 7);
                if (u < 8) oA[c4] = __builtin_amdgcn_mfma_f32_16x16x32_bf16(vf, PA, oA[c4], 0, 0, 0);
                if (u >= DLT) oB[c4] = __builtin_amdgcn_mfma_f32_16x16x32_bf16(vf, PB_, oB[c4], 0, 0, 0); }
        }
        asm volatile("s_waitcnt lgkmcnt(0)" ::: "memory");
    }
    for (int s = PRE + NU; s < NS; ++s) ROW_SYNC(s);
#undef ROW_DMA
#undef ROW_SYNC
    lA = xor32_sum(xor16_sum(lA)); lB = xor32_sum(xor16_sum(lB));
    const float invA = 1.0f / lA, invB = 1.0f / lB;
    int ce = c; asm volatile("" : "+v"(ce));
    const int gl = launder_v(lane) >> 4, dB = 8 * (gl >> 1) + 16 * (gl & 1);
    f32x4 gn[4][2];
    { const float* gnp = F_gn_att + (size_t)l * WA + h * HD + dB;
#pragma unroll
      for (int m = 0; m < 4; ++m) { gn[m][0] = *(const f32x4*)(gnp + 32 * m); gn[m][1] = *(const f32x4*)(gnp + 32 * m + 4); } }
#pragma unroll
    for (int w2 = 0; w2 < 2; ++w2) {
        f32x4 (&o)[8] = w2 ? oB : oA; const float inv = w2 ? invB : invA;
        const size_t tok = (size_t)(b * SEQ + (w2 ? rB : rA) * GW + ce);
        const bf16* gbp = F_PB + p_idx(tok, OFF_GB + h * HD) + dB;
        v4u gw_[4];
#pragma unroll
        for (int m = 0; m < 4; ++m) gw_[m] = *(const v4u*)(gbp + 32 * m);
        float ss = 0.f;
#pragma unroll
        for (int c4 = 0; c4 < 8; ++c4) { o[c4] *= inv; ss += (o[c4].x * o[c4].x + o[c4].y * o[c4].y) + (o[c4].z * o[c4].z + o[c4].w * o[c4].w); }
#pragma unroll
        for (int m = 0; m < 4; ++m)
#pragma unroll
            for (int r = 0; r < 4; ++r) { const float e0_ = o[2 * m][r], e1_ = o[2 * m + 1][r];
                const auto sw_ = __builtin_amdgcn_permlane16_swap(__builtin_bit_cast(unsigned, e0_), __builtin_bit_cast(unsigned, e1_), false, false);
                const unsigned s0_ = sw_[0], s1_ = sw_[1]; o[2 * m][r] = __builtin_bit_cast(float, s0_); o[2 * m + 1][r] = __builtin_bit_cast(float, s1_); }
#pragma unroll
        for (int m = 0; m < 4; ++m) { const f32x4 v0 = o[2 * m] * gn[m][0], v1 = o[2 * m + 1] * gn[m][1];
            v4u w; w.x = pk2(v0.x * siluf_(bflo(gw_[m].x)), v0.y * siluf_(bfhi(gw_[m].x))); w.y = pk2(v0.z * siluf_(bflo(gw_[m].y)), v0.w * siluf_(bfhi(gw_[m].y)));
            w.z = pk2(v1.x * siluf_(bflo(gw_[m].z)), v1.y * siluf_(bfhi(gw_[m].z))); w.w = pk2(v1.z * siluf_(bflo(gw_[m].w)), v1.w * siluf_(bfhi(gw_[m].w)));
            *(v4u*)(F_YC + a_tiled(tok, h * HD + 32 * m + dB)) = w; }
        ss = xor32_sum(xor16_sum(ss));
        if (gl == 0) F_SSQ[tok * NH + h] = ss;
    }
}

__device__ __forceinline__ void attn_phase(Frame& F0, KArgs A0, int l) {
    Frame F = F0; { const int t_ = launder_v((int)threadIdx.x); F.tid = t_; F.lane = t_ & 63; F.wave = __builtin_amdgcn_readfirstlane(t_ >> 6); }
    KArgs A = A0; asm volatile("" : "+s"(A));
    const int lane = F.lane;
    LAS unsigned char* ring = F.lds + RING_OFF;
    LAS float* btab = (LAS float*)(F.lds + RING_OFF + ATT_BTAB);
    const int xg = F.cid & 7, j4 = (F.cid >> 3) & 15;
    for (int it = 0; it < (BATCH * NH) / 16; ++it) {
        const int pair = xg + 8 * (2 * it + (F.cid >> 7)), b = pair >> 4, h = pair & 15;
        asm volatile("s_waitcnt vmcnt(0) lgkmcnt(0)" ::: "memory");
        __syncthreads();
        {
            const float* rpb_ = F_rpb + (size_t)(l * NH + h) * ((2 * KR - 1) * (2 * KC - 1));
            if (F.tid < 512) { const int idx = F.tid - 8; btab[F.tid] = (idx >= 0 && idx < (2 * KR - 1) * (2 * KC - 1)) ? rpb_[idx] * LOG2E : 0.f; }
        }
        __syncthreads();
        const int r0 = 4 * j4;
        const int dlt = min(max(r0 - 3, 0), ROWS - KR) - min(max(r0 - 4, 0), ROWS - KR);
        if (dlt == 0) attn_pair_task<0>(A, l, b, h, j4, F.wave, lane, ring, btab);
        else          attn_pair_task<1>(A, l, b, h, j4, F.wave, lane, ring, btab);
    }
    asm volatile("s_waitcnt vmcnt(0) lgkmcnt(0)" ::: "memory");
}

__device__ __forceinline__ void lru_fix_phase(Frame& F0, KArgs A0, int l) {
    Frame F = F0; { const int t_ = launder_v((int)threadIdx.x); F.tid = t_; F.lane = t_ & 63; F.wave = __builtin_amdgcn_readfirstlane(t_ >> 6); }
    KArgs A = A0; asm volatile("" : "+s"(A));
    const int tid = F.tid, n = F.cid & (NBLK - 1), ch4 = tid & 31, tq = tid >> 5;
    if (tid == 0) {
        gu32* flag = (gu32*)(F_ctl + CW_CREADY + 16 * (16 * l + n)); unsigned sp = 0;
        while (__hip_atomic_load(flag, RLX_AGENT) == 0u) { __builtin_amdgcn_s_sleep(2);
            if ((++sp & 1023u) == 0u && sp > (1u << 22)) { __hip_atomic_store((gu32*)(F_ctl + CW_TMO), 1u, RLX_AGENT); break; } }
        __builtin_amdgcn_fence(__ATOMIC_ACQUIRE, "agent");
        asm volatile("s_waitcnt vmcnt(0)" ::: "memory");
    }
    __syncthreads();
    const float* gl = F_gn_lru + (size_t)l * WL + n * BW + 4 * ch4;
    const f32x4 g4 = *(const f32x4*)gl;
    for (int u = F.cid; u < BATCH * NCH * NBLK; u += F.G) {
        const int pc = u >> 4, b = pc / NCH, cidx = pc % NCH, t0 = cidx * TC;
        const size_t co = (size_t)((b * NCH + cidx) * 2) * WL + n * BW + 4 * ch4;
        const unsigned long long c0 = __hip_atomic_load((gu64*)(F_CAR + co), RLX_AGENT), c1 = __hip_atomic_load((gu64*)(F_CAR + co + 2), RLX_AGENT);
        const unsigned long long d0 = __hip_atomic_load((gu64*)(F_CAR + co + WL), RLX_AGENT), d1 = __hip_atomic_load((gu64*)(F_CAR + co + WL + 2), RLX_AGENT);
        const f32x4 cf = {__builtin_bit_cast(float, (unsigned)c0), __builtin_bit_cast(float, (unsigned)(c0 >> 32)), __builtin_bit_cast(float, (unsigned)c1), __builtin_bit_cast(float, (unsigned)(c1 >> 32))};
        const f32x4 cb = {__builtin_bit_cast(float, (unsigned)d0), __builtin_bit_cast(float, (unsigned)(d0 >> 32)), __builtin_bit_cast(float, (unsigned)d1), __builtin_bit_cast(float, (unsigned)(d1 >> 32))};
        v2u lhw[4], pfw[4], pbw[4], gg[4];
#pragma unroll
        for (int i = 0; i < 4; ++i) { const size_t tok = (size_t)(b * SEQ + t0 + 4 * tq + i), o = ((size_t)((b * NCH + cidx) * NBLK + n) * TC + 4 * tq + i) * BW + 4 * ch4;
            lhw[i] = *(const v2u*)(F_LH + o); pfw[i] = *(const v2u*)(F_PF + o); pbw[i] = *(const v2u*)(F_PBK + o); gg[i] = *(const v2u*)(F_PB + p_idx(tok, OFF_GA + n * BW) + 4 * ch4); }
        float q[4];
#pragma unroll
        for (int i = 0; i < 4; ++i) { const size_t tok = (size_t)(b * SEQ + t0 + 4 * tq + i);
            const f32x4 lh = {bflo(lhw[i].x), bfhi(lhw[i].x), bflo(lhw[i].y), bfhi(lhw[i].y)}, pf = {bflo(pfw[i].x), bfhi(pfw[i].x), bflo(pfw[i].y), bfhi(pfw[i].y)}, pb = {bflo(pbw[i].x), bfhi(pbw[i].x), bflo(pbw[i].y), bfhi(pbw[i].y)};
            const f32x4 ya = lh + pf * cf + pb * cb;
            q[i] = (ya.x * ya.x + ya.y * ya.y) + (ya.z * ya.z + ya.w * ya.w);
            v2u w; w.x = pk2(ya.x * g4.x * siluf_(bflo(gg[i].x)), ya.y * g4.y * siluf_(bfhi(gg[i].x))); w.y = pk2(ya.z * g4.z * siluf_(bflo(gg[i].y)), ya.w * g4.w * siluf_(bfhi(gg[i].y)));
            *(v2u*)(F_YC + a_tiled(tok, WL + n * BW + 4 * ch4)) = w; }
#pragma unroll
        for (int i = 0; i < 4; ++i) {
#pragma unroll
            for (int o = 1; o < 32; o <<= 1) q[i] += __shfl_xor(q[i], o);
            if (ch4 == 0) F_SSA[(size_t)(b * SEQ + t0 + 4 * tq + i) * NBLK + n] = q[i]; }
    }
}

#ifndef REP_P0
#define REP_P0 1
#endif
#ifndef REP_P0A
#define REP_P0A 1
#endif
#ifndef REP_NORM
#define REP_NORM 1
#endif
#ifndef REP_G1
#define REP_G1 1
#endif
#ifndef REP_LRU
#define REP_LRU 1
#endif
#ifndef REP_ATT
#define REP_ATT 1
#endif
#ifndef REP_FIX
#define REP_FIX 1
#endif
#ifndef G1_ALIGN
#define G1_ALIGN true
#endif
#ifndef G1_SP2
#define G1_SP2 true
#endif
#ifndef G2_ALIGN
#define G2_ALIGN true
#endif
#ifndef G2_SP2
#define G2_SP2 true
#endif
constexpr int NPL = 6;
constexpr int NPHASE = 2 + NPL * DEPTH + 1;
__global__ void __launch_bounds__(NWAVES * 64, 2) trunk_fwd(Args args) {
    extern __shared__ __attribute__((aligned(16))) unsigned char lds[];
    Frame F;
    F.lds = (LAS unsigned char*)lds;
    F.MISC = (volatile LAS unsigned*)(F.lds + MISC_OFF);
    F.tid = threadIdx.x; F.lane = F.tid & 63; F.wave = __builtin_amdgcn_readfirstlane(F.tid >> 6);
    F.G = gridDim.x; { const int bx = blockIdx.x; F.vcu = (F.G % 8 == 0) ? (bx % 8) * (F.G / 8) + bx / 8 : bx; }
    KArgs A_ = (KArgs)__builtin_amdgcn_kernarg_segment_ptr(); KArgs A = A_;
    for (int u = F.tid; u < (LDS_BYTES - LDSCTL_OFF) / 4; u += NWAVES * 64) ((LAS unsigned*)(F.lds + LDSCTL_OFF))[u] = 0u;
    __syncthreads();
    XcdBarrier bar = xcd_barrier_post((unsigned*)(F_ctl + CW_BAR) + args.li * XCD_BAR_WORDS, F.MISC + 8);
    F.cid = (int)blockIdx.x;
    if (F.tid == 0) F.MISC[10] = __hip_atomic_fetch_add((unsigned*)(F_ctl + CW_RANK + 64 * (int)bar.x), 1u, __ATOMIC_RELAXED, __HIP_MEMORY_SCOPE_AGENT);
#ifndef REP_BAR
#define REP_BAR 1
#endif
#define GRID_BAR() do { for (int rb_ = 0; rb_ < REP_BAR; ++rb_) xcd_barrier(bar); } while (0)
    const int lo = args.ph_lo, hi = args.ph_hi;
#define IN(k) (lo <= (k) && (k) < hi)
#define BOTH(k) (IN(k) && IN((k) + 1))

    if (IN(0)) { for (int rep = 0; rep < REP_P0A; ++rep) p0_mod_phase(F, A); if (BOTH(0)) GRID_BAR(); }
    if (BOTH(0)) {
        if (F.tid == 0) { bool uni = (F.G == 256);
            for (int j = 0; j < 16; ++j) { const unsigned cnt = xb_ld(&bar.bar[XB_XCNT(j)]); uni = uni && (cnt == (j < 8 ? 32u : 0u)); }
            F.MISC[11] = uni ? (F.MISC[10] * 8u + bar.x) : (unsigned)blockIdx.x; }
        __syncthreads();
        F.cid = (int)F.MISC[11];
        F.vcu = (F.G % 8 == 0) ? (F.cid % 8) * (F.G / 8) + F.cid / 8 : F.cid;
    }

    if (IN(1)) { for (int rep = 0; rep < REP_P0; ++rep) p0_convert_phase(F, A);
        for (int rep = 0; rep < REP_NORM; ++rep) norm0_phase(F, A, F_x, 0);
        if (BOTH(1)) GRID_BAR(); }

    for (int l = 0; l < DEPTH; ++l) {
        const int pb = 2 + NPL * l;
        const float* xin = (l == 0) ? F_x : F_out;
        if (IN(pb + 1)) {
            KArgs A = A_; asm volatile("" : "+s"(A));
            pg8::Gemm g{F_HB, F_WIN + (size_t)l * DIN * D, M, DIN, D}; pg8::StaticOrder S; S.init(M, DIN, F.G, F.cid);
            pg8::Unit u0; S.next(0, u0);
            { LAS float* rt = (LAS float*)(F.lds + RTAB_OFF); const int t2 = launder_v((int)threadIdx.x);
              if (t2 < 256) { const f32x4* rp = (const f32x4*)(F_RS + (size_t)(u0.pm * 256 + t2) * 64); float s = 0.f;
#pragma unroll
                  for (int i = 0; i < 16; ++i) { const f32x4 v = rp[i]; s += (v.x + v.y) + (v.z + v.w); }
                  rt[t2] = 1.0f / sqrtf(s * (1.f / D) + EPS); }
              __syncthreads(); }
            pg8::EpiBf16N E{F_PB, M, F_SW + (size_t)(l * 2) * DIN, DIN, (const LAS float*)(F.lds + RTAB_OFF)};
            for (int rep = 0; rep < REP_G1; ++rep) pg8::gemm_phase<pg8::EpiBf16N, pg8::StaticOrder, G1_ALIGN, G1_SP2>(F.lds + RING_OFF, g, S, E);
            if (BOTH(pb + 1)) GRID_BAR();
        }
        if (IN(pb + 2)) { for (int rep = 0; rep < REP_LRU; ++rep) lru_local_phase(F, A, l); for (int rep = 0; rep < REP_ATT; ++rep) attn_phase(F, A, l); for (int rep = 0; rep < REP_FIX; ++rep) lru_fix_phase(F, A, l); if (BOTH(pb + 2)) GRID_BAR(); }
        if (IN(pb + 5)) {
            KArgs A = A_; asm volatile("" : "+s"(A));
            pg8::Gemm g{F_YC, F_WOUT + (size_t)l * D * D, M, D, D}; pg8::StaticOrder S; S.init(M, D, F.G, F.cid);
            pg8::Unit u0; S.next(0, u0);
            { LAS float* rt = (LAS float*)(F.lds + RTAB_OFF); const int t2 = launder_v((int)threadIdx.x);
              if (t2 < 256) { const f32x4* pa = (const f32x4*)(F_SSA + (size_t)(u0.pm * 256 + t2) * NBLK); const f32x4* pb_ = (const f32x4*)(F_SSQ + (size_t)(u0.pm * 256 + t2) * NH); float sa = 0.f, sb = 0.f;
#pragma unroll
                  for (int i = 0; i < 4; ++i) { const f32x4 va = pa[i], vb = pb_[i]; sa += (va.x + va.y) + (va.z + va.w); sb += (vb.x + vb.y) + (vb.z + vb.w); }
                  const float ra = 1.0f / sqrtf(sa * (1.f / WL) + EPS), rb = 1.0f / sqrtf(sb * (1.f / WA) + EPS);
                  rt[t2] = rb / ra; rt[256 + t2] = ra; }
              __syncthreads(); }
            const bool more = (l + 1 < DEPTH);
            pg8::EpiResid E{F_x, F_out, D, F_MOD + (size_t)(l * 2) * (3 * D) + 2 * D, 3 * D, (const LAS float*)(F.lds + RTAB_OFF),
                            (l > 0) ? F_XB : (const bf16*)nullptr, more ? F_XB : (bf16*)nullptr,
                            more ? F_HB : (bf16*)nullptr, F_norm_g + (size_t)(more ? l + 1 : l) * D, F_MOD + (size_t)((more ? l + 1 : l) * 2) * (3 * D) + D, 3 * D, F_RS};
#ifndef REP_G2L0
#define REP_G2L0 1
#endif
            for (int rep = 0; rep < ((l == 0) ? REP_G2L0 : 1); ++rep) pg8::gemm_phase<pg8::EpiResid, pg8::StaticOrder, G2_ALIGN, G2_SP2>(F.lds + RING_OFF, g, S, E);
            if (BOTH(pb + 5)) GRID_BAR();
        }
    }
    if (IN(NPHASE - 1)) final_norm_phase(F, A, F_out);
#undef IN
#undef BOTH
}

#ifndef MK_SPLIT
#define MK_SPLIT 0
#endif
extern "C" void kernel_launch(void* const* d_in, const int* in_sizes, int n_in, void* d_out, int out_size, void* d_ws, size_t ws_size, hipStream_t stream) {
    static int grid = 0;
    if (grid == 0) {
        if (n_in != 18 || in_sizes[0] != M * D || out_size != M * D || ws_size < WS_END) { fprintf(stderr, "kernel_launch: unexpected shapes (n_in %d, in0 %d, out %d, ws %zu); nothing launched\n", n_in, n_in > 0 ? in_sizes[0] : -1, out_size, ws_size); grid = -1; return; }
        int dev = 0, cus = 0, per_cu = 0;
        if (hipGetDevice(&dev) != hipSuccess || hipDeviceGetAttribute(&cus, hipDeviceAttributeMultiprocessorCount, dev) != hipSuccess) { fprintf(stderr, "kernel_launch: device query failed\n"); grid = -1; return; }
        if (hipFuncSetAttribute((const void*)trunk_fwd, hipFuncAttributeMaxDynamicSharedMemorySize, LDS_BYTES) != hipSuccess) { fprintf(stderr, "kernel_launch: hipFuncSetAttribute failed\n"); grid = -1; return; }
        if (hipOccupancyMaxActiveBlocksPerMultiprocessor(&per_cu, (const void*)trunk_fwd, NWAVES * 64, LDS_BYTES) != hipSuccess || per_cu < 1)
            fprintf(stderr, "kernel_launch: note: occupancy query reports %d workgroups per CU\n", per_cu);
        (void)hipGetLastError();
        grid = cus;
        if (cus != 256) { fprintf(stderr, "kernel_launch: built for a 256-CU device (unit orders, prologue partition); found %d CUs; nothing launched\n", cus); grid = -1; return; }
    }
    if (grid < 0) return;
    if (hipMemsetAsync((char*)d_ws + WS_CTL, 0, CTL_ZERO_BYTES, stream) != hipSuccess) { fprintf(stderr, "kernel_launch: memset failed\n"); return; }
    Args a{};
    for (int i = 0; i < 18; ++i) a.in[i] = (const float*)d_in[i];
    a.out = (float*)d_out; a.ws = (unsigned char*)d_ws; a.pad = 0;
#if MK_SPLIT
    for (int p = 0; p < NPHASE; ++p) { a.ph_lo = p; a.ph_hi = p + 1; a.li = p;
        hipLaunchKernelGGL(trunk_fwd, dim3(grid), dim3(NWAVES * 64), LDS_BYTES, stream, a);
        const hipError_t le = hipPeekAtLastError();
        if (le != hipSuccess) { fprintf(stderr, "kernel_launch: launch %d failed: %s\n", p, hipGetErrorName(le)); break; } }
#else
    a.ph_lo = 0; a.ph_hi = NPHASE; a.li = 0;
    hipLaunchKernelGGL(trunk_fwd, dim3(grid), dim3(NWAVES * 64), LDS_BYTES, stream, a);
    { const hipError_t le = hipPeekAtLastError(); if (le != hipSuccess) fprintf(stderr, "kernel_launch: launch failed: %s\n", hipGetErrorName(le)); }
#endif
}
```

```cpp
#include <hip/hip_runtime.h>
#include <cstdio>
#include <cstdint>

namespace pg8 {
#define PG8_LAS __attribute__((address_space(3)))
typedef unsigned short bf16_t;
typedef short bf16x8 __attribute__((ext_vector_type(8)));
typedef float f32x4 __attribute__((ext_vector_type(4)));
typedef unsigned u32x4 __attribute__((ext_vector_type(4)));
constexpr int BM = 256, BK = 64, HALF = 128, HTB = HALF * BK * 2  , STAGE_BYTES = 8 * HTB, NXCD = 8;
#ifndef PG8_WGM
#define PG8_WGM 8
#endif
constexpr int WGM = PG8_WGM;

__host__ __device__ __forceinline__ int lds_byte(int r, int c) { const int st = (r >> 4) * 2 + (c >> 5), rr = r & 15, cc = c & 31, ob = rr * 64 + cc * 2; return st * 1024 + (ob ^ (((ob >> 9) & 1) << 5)); }
__host__ __device__ __forceinline__ void stage_rc(int b, int& R, int& C) { const int st = b / 1024, sb = b % 1024, swz = sb ^ (((sb >> 9) & 1) << 5); R = (st >> 1) * 16 + swz / 64; C = (st & 1) * 32 + (swz % 64) / 2; }
__host__ __device__ __forceinline__ int perm32(int rho) { const int n = rho >> 4, i = rho & 15; return 8 * (i >> 2) + 4 * n + (i & 3); }

struct Unit { int pm, pn; };
struct Gemm { const bf16_t* A; const bf16_t* Bt; int M, N, K; };

struct StaticOrder {
    int nM, nN, nwg, G, c;
    __host__ __device__ void init(int M, int N, int G_, int c_) { nM = M / BM; nN = N / BM; nwg = nM * nN; G = G_; c = c_; }
    __host__ __device__ bool next(int i, Unit& u) const {
        const long L = (long)i * G + c; if (L >= nwg) return false;
        int wgid = (int)L; { const int q = nwg / NXCD, r = nwg % NXCD, xcd = wgid % NXCD, off = wgid / NXCD; wgid = (xcd < r ? xcd * (q + 1) : r * (q + 1) + (xcd - r) * q) + off; }
        const int nig = WGM * nN, gid = wgid / nig, fm = gid * WGM, gsz = (nM - fm) < WGM ? (nM - fm) : WGM;
        u.pm = fm + ((wgid % nig) % gsz); u.pn = (wgid % nig) / gsz; return true;
    }
    __device__ __forceinline__ void a_ready(const Unit&) const {}
    __device__ __forceinline__ void done(const Unit&) const {}
};

__device__ __forceinline__ unsigned cvt_pk_bf16(float lo, float hi) { unsigned r; asm volatile("v_cvt_pk_bf16_f32 %0, %1, %2" : "=v"(r) : "v"(lo), "v"(hi)); return r; }
typedef float f32x2 __attribute__((ext_vector_type(2)));

struct EpiBf16N {
    static constexpr bool PERM = true, AFTER_DRAIN = false, MIDK = false;
    bf16_t* O; int ldc; const float* sw; int swpitch; const PG8_LAS float* rtab;
    __device__ __forceinline__ void operator()(const f32x4 (&acc)[2][2][4][2], const Unit& u, int wr, int wc, int fr, int fq) const {
        const int row0 = u.pm * BM + wr * 64 + fr; const int col0 = u.pn * BM + wc * 32 + 8 * fq;
        const float* swp = sw + (size_t)((u.pm * BM) >> 12) * swpitch + col0;
        f32x4 sv[2][2];
#pragma unroll
        for (int bj = 0; bj < 2; ++bj)
#pragma unroll
            for (int n = 0; n < 2; ++n) sv[bj][n] = *(const f32x4*)(swp + bj * HALF + 4 * n);
#pragma unroll
        for (int ai = 0; ai < 2; ++ai)
#pragma unroll
            for (int m = 0; m < 4; ++m) { bf16_t* rowp = O + ((size_t)(2 * u.pn) * ldc + (row0 + ai * HALF + m * 16)) * 128 + (wc * 32 + 8 * fq); const float rs = rtab[ai * HALF + wr * 64 + m * 16 + fr];
#pragma unroll
                for (int bj = 0; bj < 2; ++bj) { const f32x4 v0 = acc[ai][bj][m][0] * rs + sv[bj][0], v1 = acc[ai][bj][m][1] * rs + sv[bj][1];
                    u32x4 w; w.x = cvt_pk_bf16(v0[0], v0[1]); w.y = cvt_pk_bf16(v0[2], v0[3]); w.z = cvt_pk_bf16(v1[0], v1[1]); w.w = cvt_pk_bf16(v1[2], v1[3]);
                    *(u32x4*)(rowp + (size_t)bj * ldc * 128) = w;
                    } }
    }
};
constexpr int M_ROWS = 8192;
struct EpiResid {
    static constexpr bool PERM = true, AFTER_DRAIN = false, MIDK = true;
    const float* xin; float* xout; int ldc; const float* gate; int gpitch; const PG8_LAS float* rtab;
    const bf16_t* xin16; bf16_t* xout16;
    bf16_t* hn; const float* gnext; const float* sclnext; int spitch; float* rs;
    __device__ __forceinline__ void midk(f32x4 (&acc)[2][2][4][2], const Unit& u, int wr, int fr) const {
#pragma unroll
        for (int ai = 0; ai < 2; ++ai)
#pragma unroll
            for (int m = 0; m < 4; ++m) { const float s = rtab[ai * HALF + wr * 64 + m * 16 + fr];
#pragma unroll
                for (int bj = 0; bj < 2; ++bj)
#pragma unroll
                    for (int n = 0; n < 2; ++n) acc[ai][bj][m][n] *= s; }
    }
    __device__ __forceinline__ void operator()(const f32x4 (&acc)[2][2][4][2], const Unit& u, int wr, int wc, int fr, int fq) const {
        const int row0 = u.pm * BM + wr * 64 + fr, col0 = u.pn * BM + wc * 32 + 8 * fq;
        const float* gp = gate + (size_t)((u.pm * BM) >> 12) * gpitch + col0;
        f32x4 gv[2][2], gs[2][2];
        const bool nx = (hn != nullptr);
#pragma unroll
        for (int bj = 0; bj < 2; ++bj)
#pragma unroll
            for (int n = 0; n < 2; ++n) { gv[bj][n] = *(const f32x4*)(gp + bj * HALF + 4 * n);
                gs[bj][n] = (f32x4){0.f, 0.f, 0.f, 0.f};
                if (nx) gs[bj][n] = *(const f32x4*)(gnext + col0 + bj * HALF + 4 * n) * (*(const f32x4*)(sclnext + (size_t)((u.pm * BM) >> 12) * spitch + col0 + bj * HALF + 4 * n) + 1.0f); }
#ifndef XW_DEPTH
#define XW_DEPTH 0
#endif
#pragma unroll
        for (int ai = 0; ai < 2; ++ai) {
            u32x4 xw[4][2];
            if (xin16) {
#pragma unroll
                for (int m = 0; m < XW_DEPTH; ++m)
#pragma unroll
                    for (int bj = 0; bj < 2; ++bj) xw[m][bj] = *(const u32x4*)(xin16 + ((size_t)((col0 + bj * HALF) >> 6) * M_ROWS + (row0 + ai * HALF + m * 16)) * 64 + ((col0 + bj * HALF) & 63));
            }
#pragma unroll
            for (int m = 0; m < 4; ++m) {
                const size_t off = (size_t)(row0 + ai * HALF + m * 16) * ldc + col0; float q = 0.f;
                const float ra = rtab[256 + ai * HALF + wr * 64 + m * 16 + fr];
                f32x4 xi[2][2];
                if (xin16) {
#pragma unroll
                    for (int bj = 0; bj < 2; ++bj) { u32x4 w;
                        if (m < XW_DEPTH) w = xw[m][bj]; else w = *(const u32x4*)(xin16 + ((size_t)((col0 + bj * HALF) >> 6) * M_ROWS + (row0 + ai * HALF + m * 16)) * 64 + ((col0 + bj * HALF) & 63));
                        xi[bj][0] = (f32x4){__builtin_bit_cast(float, w.x << 16), __builtin_bit_cast(float, w.x & 0xffff0000u), __builtin_bit_cast(float, w.y << 16), __builtin_bit_cast(float, w.y & 0xffff0000u)};
                        xi[bj][1] = (f32x4){__builtin_bit_cast(float, w.z << 16), __builtin_bit_cast(float, w.z & 0xffff0000u), __builtin_bit_cast(float, w.w << 16), __builtin_bit_cast(float, w.w & 0xffff0000u)}; }
                } else {
#pragma unroll
                    for (int bj = 0; bj < 2; ++bj)
#pragma unroll
                        for (int n = 0; n < 2; ++n) xi[bj][n] = *(const f32x4*)(xin + off + bj * HALF + 4 * n);
                }
#pragma unroll
                for (int bj = 0; bj < 2; ++bj) { f32x4 xo[2];
#pragma unroll
                    for (int n = 0; n < 2; ++n) xo[n] = xi[bj][n] + gv[bj][n] * (acc[ai][bj][m][n] * ra);
                    if (xout16) { u32x4 w; w.x = cvt_pk_bf16(xo[0][0], xo[0][1]); w.y = cvt_pk_bf16(xo[0][2], xo[0][3]); w.z = cvt_pk_bf16(xo[1][0], xo[1][1]); w.w = cvt_pk_bf16(xo[1][2], xo[1][3]);
                        *(u32x4*)(xout16 + ((size_t)((col0 + bj * HALF) >> 6) * M_ROWS + (row0 + ai * HALF + m * 16)) * 64 + ((col0 + bj * HALF) & 63)) = w; }
                    else { *(f32x4*)(xout + off + bj * HALF) = xo[0]; *(f32x4*)(xout + off + bj * HALF + 4) = xo[1]; }
                    if (nx) { q += ((xo[0][0] * xo[0][0] + xo[0][1] * xo[0][1]) + (xo[0][2] * xo[0][2] + xo[0][3] * xo[0][3])) + ((xo[1][0] * xo[1][0] + xo[1][1] * xo[1][1]) + (xo[1][2] * xo[1][2] + xo[1][3] * xo[1][3]));
                        const f32x4 h0 = xo[0] * gs[bj][0], h1 = xo[1] * gs[bj][1];
                        u32x4 w; w.x = cvt_pk_bf16(h0[0], h0[1]); w.y = cvt_pk_bf16(h0[2], h0[3]); w.z = cvt_pk_bf16(h1[0], h1[1]); w.w = cvt_pk_bf16(h1[2], h1[3]);
                        *(u32x4*)(hn + ((size_t)((col0 + bj * HALF) >> 6) * M_ROWS + (row0 + ai * HALF + m * 16)) * 64 + ((col0 + bj * HALF) & 63)) = w; } }
                if (nx) { q += __shfl_xor(q, 16); q += __shfl_xor(q, 32);
                    if (fq == 0) rs[(size_t)(row0 + ai * HALF + m * 16) * 64 + u.pn * 4 + wc] = q; }
                asm volatile("" ::: "memory"); } }
    }
};


template <class Epi, class Sched, bool ALIGN_EPI = false, bool SP2 = false>
__device__ __forceinline__ void gemm_phase(PG8_LAS unsigned char* lds, const Gemm g, const Sched& S, const Epi& E) {
    int tid_ = threadIdx.x; asm volatile("" : "+v"(tid_));
    const int tid = tid_, wid = __builtin_amdgcn_readfirstlane(tid >> 6), lane = tid & 63, wr = wid >> 2, wc = wid & 3, fr = lane & 15, fq = lane >> 4;
    const int K = g.K, nt = K / BK;
    unsigned voffA[2], voffB[2];
#pragma unroll
    for (int i = 0; i < 2; ++i) { int R, C; stage_rc(tid * 16 + i * 8192, R, C); const int Rb = Epi::PERM ? ((R & ~31) + perm32(R & 31)) : R;
        voffA[i] = (unsigned)(R * BK + C) * 2u; voffB[i] = (unsigned)(Rb * BK + C) * 2u; }
    const size_t kstepB = (size_t)g.N * BK * 2, hstepB = (size_t)HALF * BK * 2, tstepB = 2 * hstepB;
    const size_t kstepA = (size_t)g.M * BK * 2, hstepA = hstepB, tstepA = tstepB;
    const unsigned ldsw = (unsigned)wid * 1024u;
    const int aoff = lds_byte(wr * 64 + fr, fq * 8), boff = lds_byte(wc * 32 + fr, fq * 8);
#define PG8_SA(b, h) (((b) * 2 + (h)) * HTB)
#define PG8_SB(b, h) ((4 + (b) * 2 + (h)) * HTB)
#define PG8_STAGE(bufoff, gbase, voff) do { _Pragma("unroll") for (int _i = 0; _i < 2; ++_i) \
        __builtin_amdgcn_global_load_lds((const unsigned*)((const char*)(gbase) + (voff)[_i]), (PG8_LAS unsigned*)(lds + (bufoff) + ldsw + _i * 8192), 16, 0, 0); } while (0)
#define PG8_LDA(dst, b, h) do { _Pragma("unroll") for (int m = 0; m < 4; ++m) _Pragma("unroll") for (int k = 0; k < 2; ++k) dst[m][k] = *(const PG8_LAS bf16x8*)(lds + PG8_SA(b, h) + aoff + m * 2048 + k * 1024); } while (0)
#define PG8_LDB(dst, b, h) do { _Pragma("unroll") for (int n = 0; n < 2; ++n) _Pragma("unroll") for (int k = 0; k < 2; ++k) dst[n][k] = *(const PG8_LAS bf16x8*)(lds + PG8_SB(b, h) + boff + n * 2048 + k * 1024); } while (0)
#define PG8_MMA(ai, bj, At, Bt) do { __builtin_amdgcn_s_setprio(1); _Pragma("unroll") for (int m = 0; m < 4; ++m) _Pragma("unroll") for (int n = 0; n < 2; ++n) _Pragma("unroll") for (int k = 0; k < 2; ++k) \
        acc[ai][bj][m][n] = __builtin_amdgcn_mfma_f32_16x16x32_bf16(Bt[n][k], At[m][k], acc[ai][bj][m][n], 0, 0, 0); __builtin_amdgcn_s_setprio(0); } while (0)
#define PG8_WAIT_V(n) asm volatile("s_waitcnt vmcnt(" #n ")" ::: "memory")
#define PG8_WAIT_L(n) asm volatile("s_waitcnt lgkmcnt(" #n ")" ::: "memory")
#define PG8_BAR __builtin_amdgcn_s_barrier()
#define PG8_SCHED __builtin_amdgcn_sched_barrier(0)
    Unit cur, nxt; int ui = 0;
    if (!S.next(0, cur)) return;
    f32x4 acc[2][2][4][2];
#pragma unroll
    for (int a = 0; a < 2; ++a)
#pragma unroll
        for (int b = 0; b < 2; ++b)
#pragma unroll
            for (int m = 0; m < 4; ++m)
#pragma unroll
                for (int n = 0; n < 2; ++n) acc[a][b][m][n] = (f32x4){0.f, 0.f, 0.f, 0.f};
    bf16x8 At[4][2], B0[2][2], B1[2][2];
    const char* cA = (const char*)g.A + (size_t)cur.pm * tstepA; const char* cB = (const char*)g.Bt + (size_t)cur.pn * tstepB;
    S.a_ready(cur);
    if constexpr (SP2) {
        PG8_STAGE(PG8_SB(0, 0), cB, voffB); PG8_STAGE(PG8_SB(0, 1), cB + hstepB, voffB); PG8_STAGE(PG8_SA(0, 0), cA, voffA); PG8_STAGE(PG8_SA(0, 1), cA + hstepA, voffA);
        if (wr == 1) PG8_BAR;
        PG8_WAIT_V(2); PG8_BAR;
        PG8_STAGE(PG8_SB(1, 0), cB + kstepB, voffB); PG8_STAGE(PG8_SA(1, 0), cA + kstepA, voffA); PG8_STAGE(PG8_SB(1, 1), cB + hstepB + kstepB, voffB);
        PG8_WAIT_V(6); PG8_BAR;
    } else {
        PG8_STAGE(PG8_SB(0, 0), cB, voffB); PG8_STAGE(PG8_SA(0, 0), cA, voffA); PG8_STAGE(PG8_SB(0, 1), cB + hstepB, voffB); PG8_STAGE(PG8_SA(0, 1), cA + hstepA, voffA);
        if (wr == 1) PG8_BAR;
        PG8_WAIT_V(4); PG8_BAR;
        PG8_STAGE(PG8_SB(1, 0), cB + kstepB, voffB); PG8_STAGE(PG8_SA(1, 0), cA + kstepA, voffA); PG8_STAGE(PG8_SB(1, 1), cB + hstepB + kstepB, voffB);
        PG8_WAIT_V(6); PG8_BAR;
    }
    for (;;) {
        const bool has_next = S.next(ui + 1, nxt);
        const char* nA = has_next ? (const char*)g.A + (size_t)nxt.pm * tstepA : cA; const char* nB = has_next ? (const char*)g.Bt + (size_t)nxt.pn * tstepB : cB;
        for (int t = 0; t < nt; t += 2) {
            const bool last = (t == nt - 2);
            const char* a1 = cA + (size_t)(t + 1) * kstepA;
            const char* a2 = last ? nA : cA + (size_t)(t + 2) * kstepA; const char* b2 = last ? nB : cB + (size_t)(t + 2) * kstepB;
            const char* a3 = a2 + kstepA; const char* b3 = b2 + kstepB;
            if (last && has_next) S.a_ready(nxt);
            if constexpr (Epi::MIDK) { if (t == nt / 2) E.midk(acc, cur, wr, fr); }
            if constexpr (SP2) {
            PG8_LDB(B0, 0, 0); PG8_LDB(B1, 0, 1); PG8_SCHED; PG8_LDA(At, 0, 0); PG8_STAGE(PG8_SA(1, 1), a1 + hstepA, voffA);
            PG8_WAIT_V(8); PG8_WAIT_L(0); PG8_BAR; PG8_MMA(0, 0, At, B0); PG8_MMA(0, 1, At, B1); PG8_BAR; PG8_SCHED;
            PG8_LDA(At, 0, 1); PG8_STAGE(PG8_SB(0, 0), b2, voffB); PG8_STAGE(PG8_SB(0, 1), b2 + hstepB, voffB); PG8_STAGE(PG8_SA(0, 0), a2, voffA);
            PG8_WAIT_V(8); PG8_WAIT_L(0); PG8_BAR; PG8_MMA(1, 0, At, B0); PG8_MMA(1, 1, At, B1); PG8_BAR; PG8_SCHED;
            PG8_LDB(B0, 1, 0); PG8_LDB(B1, 1, 1); PG8_SCHED; PG8_LDA(At, 1, 0); PG8_STAGE(PG8_SA(0, 1), a2 + hstepA, voffA);
            PG8_WAIT_V(8); PG8_WAIT_L(0); PG8_BAR; PG8_MMA(0, 0, At, B0); PG8_MMA(0, 1, At, B1); PG8_BAR; PG8_SCHED;
            PG8_LDA(At, 1, 1); PG8_STAGE(PG8_SB(1, 0), b3, voffB); PG8_STAGE(PG8_SB(1, 1), b3 + hstepB, voffB); PG8_STAGE(PG8_SA(1, 0), a3, voffA);
            PG8_WAIT_V(8); PG8_WAIT_L(0); PG8_BAR; PG8_MMA(1, 0, At, B0); PG8_MMA(1, 1, At, B1); PG8_BAR; PG8_SCHED;
            } else {
            PG8_LDB(B0, 0, 0); PG8_SCHED; PG8_LDA(At, 0, 0); PG8_STAGE(PG8_SA(1, 1), a1 + hstepA, voffA);
            PG8_WAIT_L(8); PG8_BAR; PG8_WAIT_L(0); PG8_MMA(0, 0, At, B0); PG8_BAR; PG8_SCHED;
            PG8_LDB(B1, 0, 1); PG8_STAGE(PG8_SB(0, 0), b2, voffB);
            PG8_BAR; PG8_WAIT_L(0); PG8_MMA(0, 1, At, B1); PG8_BAR;
            PG8_LDA(At, 0, 1); PG8_STAGE(PG8_SA(0, 0), a2, voffA);
            PG8_BAR; PG8_WAIT_L(0); PG8_MMA(1, 0, At, B0); PG8_BAR; PG8_SCHED;
            PG8_STAGE(PG8_SB(0, 1), b2 + hstepB, voffB);
            PG8_WAIT_V(6); PG8_BAR; PG8_MMA(1, 1, At, B1); PG8_BAR;
            PG8_LDB(B0, 1, 0); PG8_SCHED; PG8_LDA(At, 1, 0); PG8_STAGE(PG8_SA(0, 1), a2 + hstepA, voffA);
            PG8_WAIT_L(8); PG8_BAR; PG8_WAIT_L(0); PG8_MMA(0, 0, At, B0); PG8_BAR; PG8_SCHED;
            PG8_LDB(B1, 1, 1); PG8_STAGE(PG8_SB(1, 0), b3, voffB);
            PG8_BAR; PG8_WAIT_L(0); PG8_MMA(0, 1, At, B1); PG8_BAR;
            PG8_LDA(At, 1, 1); PG8_STAGE(PG8_SA(1, 0), a3, voffA);
            PG8_BAR; PG8_WAIT_L(0); PG8_MMA(1, 0, At, B0); PG8_BAR; PG8_SCHED;
            PG8_STAGE(PG8_SB(1, 1), b3 + hstepB, voffB);
            PG8_WAIT_V(6); PG8_BAR; PG8_MMA(1, 1, At, B1); PG8_BAR;
            }
        }
        if constexpr (ALIGN_EPI) { if (wr == 0) PG8_BAR; }
        if constexpr (!Epi::AFTER_DRAIN) { E(acc, cur, wr, wc, fr, fq); S.done(cur); }
        if (!has_next) break;
#pragma unroll
        for (int a = 0; a < 2; ++a)
#pragma unroll
            for (int b = 0; b < 2; ++b)
#pragma unroll
                for (int m = 0; m < 4; ++m)
#pragma unroll
                    for (int n = 0; n < 2; ++n) acc[a][b][m][n] = (f32x4){0.f, 0.f, 0.f, 0.f};
        cur = nxt; cA = nA; cB = nB; ++ui;
        if constexpr (ALIGN_EPI) { if (wr == 1) PG8_BAR; }
    }
    PG8_WAIT_V(0);
    if constexpr (!ALIGN_EPI) { if (wr == 0) PG8_BAR; }
    PG8_BAR;
    if constexpr (Epi::AFTER_DRAIN) { E.fused(acc, cur, wr, wc, fr, fq, lds, wid, lane); S.done(cur); }
#undef PG8_SA
#undef PG8_SB
#undef PG8_STAGE
#undef PG8_LDA
#undef PG8_LDB
#undef PG8_MMA
#undef PG8_WAIT_V
#undef PG8_WAIT_L
#undef PG8_BAR
#undef PG8_SCHED
}
}

#ifndef PG8_SP2
#define PG8_SP2 true
#endif
#ifndef PG8_ALIGN
#define PG8_ALIGN true
#endif

constexpr int NWAVES = 8;
constexpr int D = 4096, BATCH = 2, SEQ = 4096, DEPTH = 4, M = BATCH * SEQ;
constexpr int WL = 2048, WA = 2048, NBLK = 16, BW = 128, NH = 16, HD = 128, GW = 64, ROWS = 64, KR = 8, KC = 16;
constexpr int DIN = 2 * WL + 4 * WA;
constexpr int PP = DIN + 128;
constexpr int OFF_XA = 0, OFF_GA = WL, OFF_Q = 2 * WL, OFF_K = 2 * WL + WA, OFF_V = 2 * WL + 2 * WA, OFF_GB = 2 * WL + 3 * WA;
constexpr float EPS = 1e-6f, C_RG = 8.0f;
constexpr int TC = 64, NCH = SEQ / TC;

constexpr size_t MiB = 1u << 20;
constexpr size_t WS_CTL = 0, CTL_ZERO_BYTES = 1 * MiB;
constexpr size_t WS_MOD = 1 * MiB;
constexpr size_t WS_SW = 1 * MiB + 512 * 1024;
constexpr size_t WS_WAT = 2 * MiB, WS_WXT = 6 * MiB;
constexpr size_t WS_WIN = 16 * MiB;
constexpr size_t WS_WOUT = 400 * MiB;
constexpr size_t WS_H = 528 * MiB;
constexpr size_t WS_P = 1088 * MiB;
constexpr size_t WS_YC = 784 * MiB;
constexpr size_t WS_LH = 848 * MiB, WS_PF = 912 * MiB, WS_PB = 976 * MiB;
constexpr size_t WS_SUM = 1040 * MiB;
constexpr size_t WS_CAR = 1048 * MiB;
constexpr size_t WS_YB = 1052 * MiB;
constexpr size_t WS_SSQ = 1084 * MiB;
constexpr size_t WS_SSA = 1085 * MiB + 512 * 1024;
constexpr size_t WS_XB = 1284 * MiB;
constexpr size_t WS_RS = 1086 * MiB;
constexpr size_t WS_END = 1348 * MiB;
static_assert(WS_SUM + (size_t)BATCH * NCH * 2 * WL * 2 * 4 <= WS_CAR && WS_CAR + (size_t)BATCH * NCH * 2 * WL * 4 <= WS_YB && WS_YB + (size_t)M * WA * 2 <= WS_SSQ && WS_SSQ + (size_t)M * NH * 4 <= WS_END, "d_ws map (scan scratch)");
static_assert(WS_MOD + (size_t)DEPTH * 2 * 3 * D * 4 <= WS_SW && WS_SW + (size_t)DEPTH * 2 * DIN * 4 <= WS_WAT && WS_WAT + (size_t)DEPTH * 2 * NBLK * BW * BW * 2 <= WS_WXT && WS_WXT + (size_t)DEPTH * 2 * NBLK * BW * BW * 2 <= WS_WIN, "d_ws map (small)");
static_assert(WS_WIN + (size_t)DEPTH * DIN * D * 2 <= WS_WOUT && WS_WOUT + (size_t)DEPTH * D * D * 2 <= WS_H && WS_H + (size_t)M * D * 2 <= WS_YC && WS_P + (size_t)M * PP * 2 <= WS_END && WS_YC + (size_t)M * D * 2 <= WS_LH, "d_ws map (big)");
static_assert(WS_LH + (size_t)M * WL * 4 <= WS_PF && WS_PF + (size_t)M * WL * 4 <= WS_PB && WS_PB + (size_t)M * WL * 4 <= WS_SUM, "d_ws map (lru)");
constexpr int CW_TMO = 0, CW_CODE = 1;
constexpr int CW_CARRY = 1024;
constexpr int CW_CREADY = 3072;
constexpr int CW_RANK = 2048;
constexpr int CW_BAR = 4096;

constexpr int RING_OFF = 0, RING_BYTES = 131072;
constexpr int LDS_BYTES = 147456;
constexpr int LDSCTL_OFF = LDS_BYTES - 3072, MISC_OFF = LDSCTL_OFF + 320;
constexpr int RTAB_OFF = LDSCTL_OFF + 1024;
constexpr int PHASE_LDS = LDSCTL_OFF;
static_assert(RING_BYTES <= PHASE_LDS && MISC_OFF + 128 <= RTAB_OFF && RTAB_OFF + 2048 <= LDS_BYTES, "LDS map");

#define GAS __attribute__((address_space(1)))
#define LAS __attribute__((address_space(3)))
typedef unsigned short bf16;
typedef unsigned v4u __attribute__((ext_vector_type(4)));
typedef unsigned v2u __attribute__((ext_vector_type(2)));
typedef float f32x4 __attribute__((ext_vector_type(4)));
typedef short bf16x8 __attribute__((ext_vector_type(8)));
typedef GAS unsigned gu32;
typedef GAS unsigned long long gu64;
#define RLX_AGENT __ATOMIC_RELAXED, __HIP_MEMORY_SCOPE_AGENT
#define LDS_WAIT() asm volatile("s_waitcnt lgkmcnt(0)" ::: "memory")
#define VM_WAIT() asm volatile("s_waitcnt vmcnt(0)" ::: "memory")
__device__ __forceinline__ unsigned f2bf(float f) { unsigned u = __builtin_bit_cast(unsigned, f); return (u + 0x7fffu + ((u >> 16) & 1u)) >> 16; }
typedef float f32x2_t __attribute__((ext_vector_type(2))); typedef __bf16 bf16x2_t __attribute__((ext_vector_type(2)));
__device__ __forceinline__ unsigned pk2(float lo, float hi) { const f32x2_t v = {lo, hi}; return __builtin_bit_cast(unsigned, __builtin_convertvector(v, bf16x2_t)); }
__device__ __forceinline__ size_t a_tiled(size_t row, int col) { return ((size_t)(col >> 6) * M + row) * 64 + (col & 63); }
__device__ __forceinline__ size_t p_idx(size_t tok, int col) { return ((size_t)(col >> 7) * M + tok) * 128 + (col & 127); }
__device__ __forceinline__ float bf2f(unsigned short b) { return __builtin_bit_cast(float, ((unsigned)b) << 16); }
__device__ __forceinline__ float bflo(unsigned w) { return __builtin_bit_cast(float, w << 16); }
__device__ __forceinline__ float bfhi(unsigned w) { return __builtin_bit_cast(float, w & 0xffff0000u); }
__device__ __forceinline__ float sigmoidf_(float v) { return 1.0f / (1.0f + __expf(-v)); }
__device__ __forceinline__ float siluf_(float v) { return v / (1.0f + __expf(-v)); }


#define XB_TMO      128
#define XB_XCNT(j)  (256  + 64 * (j))
#define XB_XSUB(j)  (1280 + 64 * (j))
#define XB_XGEN(j)  (2304 + 64 * (j))
#define XB_TOP      3328
#define XB_TOPGEN   3392
#define XCD_BAR_WORDS 3456
#define XB_SPIN_CAP (1u << 18)

__device__ __forceinline__ unsigned xb_ld(unsigned* p)              { return __hip_atomic_load(p, __ATOMIC_RELAXED, __HIP_MEMORY_SCOPE_AGENT); }
__device__ __forceinline__ unsigned xb_add(unsigned* p, unsigned v) { return __hip_atomic_fetch_add(p, v, __ATOMIC_RELAXED, __HIP_MEMORY_SCOPE_AGENT); }
__device__ __forceinline__ unsigned xb_xcc_id() { return (unsigned)__builtin_amdgcn_s_getreg((3 << 11) | 20) & 0xFu; }
#define XB_SPIN(cond, bar) do { unsigned _sp = 0; while (cond) { __builtin_amdgcn_s_sleep(1); \
    if ((++_sp & 255u) == 0u) { if (xb_ld(&(bar)[XB_TMO])) break; if (_sp > XB_SPIN_CAP) { atomicAdd(&(bar)[XB_TMO], 1u); break; } } } } while (0)

struct XcdBarrier {
    unsigned* bar; unsigned x;
    volatile LAS unsigned* st;
};

__device__ __forceinline__ XcdBarrier xcd_barrier_post(unsigned* bar, volatile LAS unsigned* st) {
    XcdBarrier b; b.bar = bar; b.x = xb_xcc_id(); b.st = st;
    if (threadIdx.x == 0) (void)xb_add(&bar[XB_XCNT(b.x)], 1u);
    return b;
}
__device__ __forceinline__ void xcd_barrier_complete(unsigned* bar, unsigned x, unsigned& nloc, unsigned& nx) {
    const unsigned G = gridDim.x * gridDim.y * gridDim.z;
    unsigned sum, cnt, mine, sp = 0u;
    for (;;) {
        sum = 0u; cnt = 0u; mine = 0u;
#pragma unroll
        for (unsigned j = 0; j < 16; ++j) { const unsigned c = xb_ld(&bar[XB_XCNT(j)]); sum += c; cnt += (c > 0u) ? 1u : 0u; mine = (j == x) ? c : mine; }
        if (sum == G) break;
        __builtin_amdgcn_s_sleep(1);
        if ((++sp & 255u) == 0u) { if (xb_ld(&bar[XB_TMO])) break; if (sp > XB_SPIN_CAP) { atomicAdd(&bar[XB_TMO], 1u); break; } }
    }
    nloc = mine > 0u ? mine : 1u; nx = cnt > 0u ? cnt : 1u;
}

__device__ __forceinline__ void xcd_barrier(const XcdBarrier& b) {
    asm volatile("s_waitcnt vmcnt(0)" ::: "memory");
    __syncthreads();
    if (threadIdx.x == 0) {
        unsigned* bar = b.bar;
        __builtin_amdgcn_s_waitcnt(0);
        unsigned nloc = b.st[0], nx = b.st[1];
        if (nloc == 0u) { xcd_barrier_complete(bar, b.x, nloc, nx); b.st[0] = nloc; b.st[1] = nx; }
        const unsigned old = xb_add(&bar[XB_XSUB(b.x)], 1u);
        const unsigned gen = old / nloc;
        if (old + 1u == (gen + 1u) * nloc) {
            __builtin_amdgcn_fence(__ATOMIC_RELEASE, "agent");
            asm volatile("s_waitcnt vmcnt(0)" ::: "memory");
            const unsigned og = xb_add(&bar[XB_TOP], 1u);
            const unsigned tg = og / nx;
            if (og + 1u == (tg + 1u) * nx) xb_add(&bar[XB_TOPGEN], 1u);
            else XB_SPIN(xb_ld(&bar[XB_TOPGEN]) == tg, bar);
            __builtin_amdgcn_fence(__ATOMIC_ACQUIRE, "agent");
            xb_add(&bar[XB_XGEN(b.x)], 1u);
            asm volatile("s_waitcnt vmcnt(0)" ::: "memory");
        } else {
            XB_SPIN(xb_ld(&bar[XB_XGEN(b.x)]) == gen, bar);
            __builtin_amdgcn_fence(__ATOMIC_ACQUIRE, "agent");
            asm volatile("s_waitcnt vmcnt(0)" ::: "memory");
        }
    }
    __syncthreads();
}


struct Args { const float* in[18]; float* out; unsigned char* ws; int ph_lo, ph_hi, li, pad; };
typedef const __attribute__((address_space(4))) Args* KArgs;
struct Frame {
    LAS unsigned char* lds;
    volatile LAS unsigned* MISC;
    int tid, lane, wave;
    int vcu, G, cid;
};
#define F_x          (A->in[0])
#define F_c          (A->in[1])
#define F_norm_g     (A->in[2])
#define F_w_ada      (A->in[3])
#define F_b_ada      (A->in[4])
#define F_w_in       (A->in[5])
#define F_conv_w     (A->in[6])
#define F_conv_b     (A->in[7])
#define F_lru_wa     (A->in[8])
#define F_lru_ba     (A->in[9])
#define F_lru_wx     (A->in[10])
#define F_lru_bx     (A->in[11])
#define F_lru_lambda (A->in[12])
#define F_rpb        (A->in[13])
#define F_gn_lru     (A->in[14])
#define F_gn_att     (A->in[15])
#define F_w_out      (A->in[16])
#define F_final_g    (A->in[17])
#define F_out        (A->out)
#define F_ctl        ((gu32*)(A->ws + WS_CTL))
#define F_MOD        ((float*)(A->ws + WS_MOD))
#define F_WAT        ((bf16*)(A->ws + WS_WAT))
#define F_WXT        ((bf16*)(A->ws + WS_WXT))
#define F_WIN        ((bf16*)(A->ws + WS_WIN))
#define F_WOUT       ((bf16*)(A->ws + WS_WOUT))
#define F_HB         ((bf16*)(A->ws + WS_H))
#define F_PB         ((bf16*)(A->ws + WS_P))
#define F_YC         ((bf16*)(A->ws + WS_YC))
#define F_YB         ((bf16*)(A->ws + WS_YB))
#define F_LH         ((bf16*)(A->ws + WS_LH))
#define F_PF         ((bf16*)(A->ws + WS_PF))
#define F_PBK        ((bf16*)(A->ws + WS_PB))
#define F_SUM        ((float*)(A->ws + WS_SUM))
#define F_CAR        ((float*)(A->ws + WS_CAR))
#define F_SSQ        ((float*)(A->ws + WS_SSQ))
#define F_SSA        ((float*)(A->ws + WS_SSA))
#define F_SW         ((float*)(A->ws + WS_SW))
#define F_XB         ((bf16*)(A->ws + WS_XB))
#define F_RS         ((float*)(A->ws + WS_RS))

__device__ __forceinline__ float wave_sum(float v) {
#pragma unroll
    for (int o = 1; o < 64; o <<= 1) v += __shfl_xor(v, o);
    return v;
}


__device__ __forceinline__ int launder_v(int v) { asm volatile("" : "+v"(v)); return v; }
__device__ __forceinline__ float xor16_max(float x) { const auto s = __builtin_amdgcn_permlane16_swap(__builtin_bit_cast(unsigned, x), __builtin_bit_cast(unsigned, x), false, false);
    const unsigned s0 = s[0], s1 = s[1]; return fmaxf(__builtin_bit_cast(float, s0), __builtin_bit_cast(float, s1)); }
__device__ __forceinline__ float xor32_max(float x) { const auto s = __builtin_amdgcn_permlane32_swap(__builtin_bit_cast(unsigned, x), __builtin_bit_cast(unsigned, x), false, false);
    const unsigned s0 = s[0], s1 = s[1]; return fmaxf(__builtin_bit_cast(float, s0), __builtin_bit_cast(float, s1)); }
__device__ __forceinline__ float xor16_sum(float x) { const auto s = __builtin_amdgcn_permlane16_swap(__builtin_bit_cast(unsigned, x), __builtin_bit_cast(unsigned, x), false, false);
    const unsigned s0 = s[0], s1 = s[1]; return __builtin_bit_cast(float, s0) + __builtin_bit_cast(float, s1); }
__device__ __forceinline__ float xor32_sum(float x) { const auto s = __builtin_amdgcn_permlane32_swap(__builtin_bit_cast(unsigned, x), __builtin_bit_cast(unsigned, x), false, false);
    const unsigned s0 = s[0], s1 = s[1]; return __builtin_bit_cast(float, s0) + __builtin_bit_cast(float, s1); }

#ifndef P0_WIDE
#define P0_WIDE 0
#endif
__device__ __forceinline__ void p0_fetch(float (&rg)[32], const float* W, int N, int item, int lane) {
    const int nblk = N / 32, kb = item / nblk, nb = item % nblk, k0 = 64 * kb, n0 = 32 * nb;
#if P0_WIDE
    const float* p = W + (size_t)(k0 + (lane >> 3)) * N + n0 + 4 * (lane & 7);
#pragma unroll
    for (int i = 0; i < 8; ++i) { const f32x4 v = __builtin_nontemporal_load((const f32x4*)(p + (size_t)(8 * i) * N)); rg[4 * i] = v.x; rg[4 * i + 1] = v.y; rg[4 * i + 2] = v.z; rg[4 * i + 3] = v.w; }
#else
    const float* p = W + (size_t)(k0 + (lane >> 5)) * N + n0 + (lane & 31);
#pragma unroll
    for (int i = 0; i < 32; ++i) rg[i] = __builtin_nontemporal_load(p + (size_t)(2 * i) * N);
#endif
}
__device__ __forceinline__ void p0_stash(const float (&rg)[32], LAS float* scr, int lane) {
#if P0_WIDE
#pragma unroll
    for (int i = 0; i < 8; ++i) { LAS float* d = scr + (8 * i + (lane >> 3)) * 33 + 4 * (lane & 7); d[0] = rg[4 * i]; d[1] = rg[4 * i + 1]; d[2] = rg[4 * i + 2]; d[3] = rg[4 * i + 3]; }
#else
#pragma unroll
    for (int i = 0; i < 32; ++i) scr[(2 * i + (lane >> 5)) * 33 + (lane & 31)] = rg[i];
#endif
}
__device__ __forceinline__ void p0_transpose_load(const float* W, int N, LAS float* scr, int item, int lane) {
    float rg[32]; p0_fetch(rg, W, N, item, lane); p0_stash(rg, scr, lane);
}
template <bool TILED>
__device__ __forceinline__ void p0_transpose_store(int K, int N, bf16* WT, LAS float* scr, int item, int lane, int krot) {
    const int nblk = N / 32, kb = item / nblk, nb = item % nblk, k0 = 64 * kb, n0 = 32 * nb;
    const int c = lane & 7;
#pragma unroll
    for (int j = 0; j < 4; ++j) { const int n = (lane >> 3) + 8 * j; const LAS float* s = scr + (8 * c) * 33 + n;
        v4u o; o.x = pk2(s[0 * 33], s[1 * 33]); o.y = pk2(s[2 * 33], s[3 * 33]); o.z = pk2(s[4 * 33], s[5 * 33]); o.w = pk2(s[6 * 33], s[7 * 33]);
#ifdef WT_NT
        __builtin_nontemporal_store(o, (GAS v4u*)(WT + (TILED ? ((size_t)(((k0 + krot) & (K - 1)) >> 6) * N + n0 + n) * 64 : (size_t)(n0 + n) * K + ((k0 + krot) & (K - 1))) + 8 * c)); }
#else
        *(GAS v4u*)(WT + (TILED ? ((size_t)(((k0 + krot) & (K - 1)) >> 6) * N + n0 + n) * 64 : (size_t)(n0 + n) * K + ((k0 + krot) & (K - 1))) + 8 * c) = o; }
#endif
    LDS_WAIT(); asm volatile("" ::: "memory");
}
template <bool TILED>
__device__ __forceinline__ void p0_transpose_item(const float* W, int K, int N, bf16* WT, LAS float* scr, int item, int lane, int krot = 0) {
    p0_transpose_load(W, N, scr, item, lane);
    LDS_WAIT(); asm volatile("" ::: "memory");
    p0_transpose_store<TILED>(K, N, WT, scr, item, lane, krot);
}

__device__ __forceinline__ void p0_mod_phase(Frame& F0, KArgs A0) {
    Frame F = F0; { const int t_ = launder_v((int)threadIdx.x); F.tid = t_; F.lane = t_ & 63; F.wave = __builtin_amdgcn_readfirstlane(t_ >> 6); }
    KArgs A = A0; asm volatile("" : "+s"(A));
    {
        __syncthreads();
        LAS float* cond = (LAS float*)(F.lds + RING_OFF);
        LAS float* red = (LAS float*)(F.lds + RING_OFF + 32768);
        for (int i = F.tid; i < 2 * D; i += NWAVES * 64) { const float v = F_c[i]; cond[i] = siluf_(v); }
        __syncthreads();
        const int c4 = F.lane & 31, half = F.lane >> 5; const bool act = c4 < 24;
        for (int it = blockIdx.x; it < DEPTH * 128; it += F.G) {
            const int l = it >> 7, cg = it & 127;
            const float* W = F_w_ada + (size_t)l * D * (3 * D) + cg * 96 + 4 * (act ? c4 : 0);
            const int kbase = F.wave * 512 + half;
            f32x4 a0 = {0.f, 0.f, 0.f, 0.f}, a1 = {0.f, 0.f, 0.f, 0.f};
            if (act) {
#pragma unroll 8
                for (int i = 0; i < 256; ++i) { const int k = kbase + 2 * i;
                    const f32x4 w = __builtin_nontemporal_load((const f32x4*)(W + (size_t)k * (3 * D)));
                    const float s0 = cond[k], s1 = cond[D + k]; a0 += w * s0; a1 += w * s1; }
            }
#pragma unroll
            for (int j = 0; j < 4; ++j) { a0[j] += __shfl_xor(a0[j], 32); a1[j] += __shfl_xor(a1[j], 32); }
            if (half == 0 && act) {
#pragma unroll
                for (int j = 0; j < 4; ++j) { red[(F.wave * 2 + 0) * 96 + 4 * c4 + j] = a0[j]; red[(F.wave * 2 + 1) * 96 + 4 * c4 + j] = a1[j]; } }
            __syncthreads();
            if (F.tid < 192) { const int b = F.tid / 96, cc = F.tid % 96; float s = 0.f;
#pragma unroll
                for (int w = 0; w < 8; ++w) s += red[(w * 2 + b) * 96 + cc];
                F_MOD[(size_t)(l * 2 + b) * (3 * D) + cg * 96 + cc] = s + F_b_ada[(size_t)l * (3 * D) + cg * 96 + cc]; }
            __syncthreads();
        }
    }
}

__device__ __forceinline__ void p0_convert_phase(Frame& F0, KArgs A0) {
    Frame F = F0; { const int t_ = launder_v((int)threadIdx.x); F.tid = t_; F.lane = t_ & 63; F.wave = __builtin_amdgcn_readfirstlane(t_ >> 6); }
    KArgs A = A0; asm volatile("" : "+s"(A));
    LAS float* scr = (LAS float*)(F.lds + RING_OFF + F.wave * 16384);
    LAS float* shv = scr + 64 * 33;
    const int gw = F.vcu * NWAVES + F.wave;
    constexpr int NB_IN = DIN / 32, N_BIG = DEPTH * NB_IN;
    constexpr int I_OUT = (D / 64) * (D / 32), I_G = 8, N_OUT = DEPTH * I_OUT, N_G = DEPTH * 2 * NBLK * I_G;
    if (gw < N_BIG) {
        const int l = gw / NB_IN, nb = gw % NB_IN, n = F.lane & 31, b = F.lane >> 5;
        const float* W = F_w_in + (size_t)l * D * DIN; bf16* WT = F_WIN + (size_t)l * DIN * D;
        float acc = 0.f;
        for (int kb = 0; kb < D / 64; ++kb) {
            const float s0 = F_MOD[(size_t)(l * 2 + 0) * (3 * D) + 64 * kb + F.lane], s1 = F_MOD[(size_t)(l * 2 + 1) * (3 * D) + 64 * kb + F.lane];
            p0_transpose_load(W, DIN, scr, kb * NB_IN + nb, F.lane);
            shv[F.lane] = s0; shv[64 + F.lane] = s1;
            LDS_WAIT(); asm volatile("" ::: "memory");
#pragma unroll 16
            for (int kk = 0; kk < 64; ++kk) acc = __builtin_fmaf(shv[b * 64 + kk], scr[kk * 33 + n], acc);
            p0_transpose_store<true>(D, DIN, WT, scr, kb * NB_IN + nb, F.lane, 0);
        }
        F_SW[(size_t)(l * 2 + b) * DIN + 32 * nb + n] = acc;
    } else {
        for (int it = gw - N_BIG; it < N_OUT + 2 * N_G; it += F.G * NWAVES - N_BIG) {
            int r = it;
            if (r < N_OUT) { const int l = r / I_OUT; p0_transpose_item<true>(F_w_out + (size_t)l * D * D, D, D, F_WOUT + (size_t)l * D * D, scr, r % I_OUT, F.lane, WL); continue; } r -= N_OUT;
            if (r < N_G) { const int mt = r / I_G; p0_transpose_item<false>(F_lru_wa + (size_t)mt * BW * BW, BW, BW, F_WAT + (size_t)mt * BW * BW, scr, r % I_G, F.lane); continue; } r -= N_G;
            { const int mt = r / I_G; p0_transpose_item<false>(F_lru_wx + (size_t)mt * BW * BW, BW, BW, F_WXT + (size_t)mt * BW * BW, scr, r % I_G, F.lane); }
        }
    }
}

__device__ __forceinline__ void norm0_phase(Frame& F0, KArgs A0, const float* x, int l) {
    Frame F = F0; { const int t_ = launder_v((int)threadIdx.x); F.tid = t_; F.lane = t_ & 63; F.wave = __builtin_amdgcn_readfirstlane(t_ >> 6); }
    KArgs A = A0; asm volatile("" : "+s"(A));
    const int gw = F.vcu * NWAVES + F.wave, NGW = F.G * NWAVES;
    const float* g = F_norm_g + (size_t)l * D;
    for (int m = gw; m < M; m += NGW) {
        const float* modp = F_MOD + (size_t)(l * 2 + (m >> 12)) * (3 * D);
        const GAS f32x4* xr = (const GAS f32x4*)(x + (size_t)m * D) + F.lane;
        f32x4 v[16]; float s = 0.f;
#pragma unroll
        for (int j = 0; j < 16; ++j) { v[j] = xr[64 * j]; s += (v[j].x * v[j].x + v[j].y * v[j].y) + (v[j].z * v[j].z + v[j].w * v[j].w); }
        s = wave_sum(s);
        F_RS[(size_t)m * 64 + F.lane] = (F.lane == 0) ? s : 0.f;
        bf16* hb = F_HB;
#pragma unroll
        for (int j = 0; j < 16; ++j) { const int col = 4 * F.lane + 256 * j;
            const f32x4 g4 = *(const f32x4*)(g + col), sc = *(const f32x4*)(modp + D + col);
            const f32x4 o = v[j] * g4 * (sc + 1.0f);
            v2u w; w.x = pk2(o.x, o.y); w.y = pk2(o.z, o.w); *(GAS v2u*)(hb + a_tiled((size_t)m, col)) = w; }
    }
}

__device__ __forceinline__ void final_norm_phase(Frame& F0, KArgs A0, float* x) {
    Frame F = F0; { const int t_ = launder_v((int)threadIdx.x); F.tid = t_; F.lane = t_ & 63; F.wave = __builtin_amdgcn_readfirstlane(t_ >> 6); }
    KArgs A = A0; asm volatile("" : "+s"(A));
    const int gw = F.vcu * NWAVES + F.wave, NGW = F.G * NWAVES;
    for (int m = gw; m < M; m += NGW) {
        GAS f32x4* xr = (GAS f32x4*)(x + (size_t)m * D) + F.lane;
        f32x4 v[16]; float s = 0.f;
#pragma unroll
        for (int j = 0; j < 16; ++j) { v[j] = xr[64 * j]; s += (v[j].x * v[j].x + v[j].y * v[j].y) + (v[j].z * v[j].z + v[j].w * v[j].w); }
        const float rstd = 1.0f / sqrtf(wave_sum(s) * (1.f / D) + EPS);
#pragma unroll
        for (int j = 0; j < 16; ++j) { const f32x4 g4 = *(const f32x4*)(F_final_g + 4 * F.lane + 256 * j); xr[64 * j] = (v[j] * rstd) * g4; }
    }
}

typedef float f32x16 __attribute__((ext_vector_type(16)));
constexpr int X16P = 136;
constexpr int LRU_X32 = 0, LRU_X16 = TC * BW * 4, LRU_RES = LRU_X16 + TC * X16P * 2, LRU_END = LRU_RES + 2 * TC * BW * 4;
static_assert(LRU_END <= RING_BYTES && (LRU_X16 % 16) == 0 && (LRU_RES % 16) == 0, "LRU LDS map");
constexpr float LOG2E = 1.4426950408889634f;

template <int E>
__device__ __forceinline__ void lru_tile(const f32x16& accR, const f32x16& accI, const LAS float* xrow, LAS unsigned* rrow, int h, float bR, float bI, float c1, float& Hc, float& Pc) {
    float a[16], bb[16];
    typedef float f2 __attribute__((ext_vector_type(2)));
    const float nbR = -LOG2E * bR, nbI = -LOG2E * bI;
#pragma unroll
    for (int rp = 0; rp < 8; ++rp) {
        const int r0 = 2 * rp, r1 = r0 + 1;
        const f2 xc = {xrow[((r0 & 3) + 8 * (r0 >> 2)) * BW], xrow[((r1 & 3) + 8 * (r1 >> 2)) * BW]};
        const f2 er = (f2){accR[r0], accR[r1]} * (-LOG2E) + nbR, ei = (f2){accI[r0], accI[r1]} * (-LOG2E) + nbI;
        const f2 dr = (f2){__builtin_amdgcn_exp2f(er.x), __builtin_amdgcn_exp2f(er.y)} + 1.0f, di = (f2){__builtin_amdgcn_exp2f(ei.x), __builtin_amdgcn_exp2f(ei.y)} + 1.0f;
        const f2 r = {__builtin_amdgcn_rcpf(dr.x), __builtin_amdgcn_rcpf(dr.y)}, ig = {__builtin_amdgcn_rcpf(di.x), __builtin_amdgcn_rcpf(di.y)};
        const f2 ca = r * c1;
        const f2 av = {__builtin_amdgcn_exp2f(ca.x), __builtin_amdgcn_exp2f(ca.y)};
        const f2 om = 1.0f - av * av;
        const f2 sq = {__builtin_amdgcn_sqrtf(om.x), __builtin_amdgcn_sqrtf(om.y)};
        const f2 bv = sq * (ig * xc);
        a[r0] = av.x; a[r1] = av.y; bb[r0] = bv.x; bb[r1] = bv.y;
    }
    float lcl[16], p[16], As[4], Bs[4], Ao[4], Bo[4];
#pragma unroll
    for (int g = 0; g < 4; ++g) {
        if (E == 0) {
            lcl[4 * g] = bb[4 * g]; p[4 * g] = a[4 * g];
#pragma unroll
            for (int i = 1; i < 4; ++i) { lcl[4 * g + i] = __builtin_fmaf(a[4 * g + i], lcl[4 * g + i - 1], bb[4 * g + i]); p[4 * g + i] = a[4 * g + i] * p[4 * g + i - 1]; }
            As[g] = p[4 * g + 3]; Bs[g] = lcl[4 * g + 3];
        } else {
            lcl[4 * g + 3] = bb[4 * g + 3]; p[4 * g + 3] = a[4 * g + 3];
#pragma unroll
            for (int i = 2; i >= 0; --i) { lcl[4 * g + i] = __builtin_fmaf(a[4 * g + i], lcl[4 * g + i + 1], bb[4 * g + i]); p[4 * g + i] = a[4 * g + i] * p[4 * g + i + 1]; }
            As[g] = p[4 * g]; Bs[g] = lcl[4 * g];
        }
        { const auto ta = __builtin_amdgcn_permlane32_swap(__builtin_bit_cast(unsigned, As[g]), __builtin_bit_cast(unsigned, As[g]), false, false);
          const auto tb = __builtin_amdgcn_permlane32_swap(__builtin_bit_cast(unsigned, Bs[g]), __builtin_bit_cast(unsigned, Bs[g]), false, false);
          const unsigned a0_ = ta[0], a1_ = ta[1], b0_ = tb[0], b1_ = tb[1];
          As[g] = __builtin_bit_cast(float, a0_); Ao[g] = __builtin_bit_cast(float, a1_); Bs[g] = __builtin_bit_cast(float, b0_); Bo[g] = __builtin_bit_cast(float, b1_); }
    }
    float cinH[4], cinP[4];
#pragma unroll
    for (int gg = 0; gg < 4; ++gg) {
        const int g = (E == 0) ? gg : (3 - gg);
        const float A0 = As[g], B0 = Bs[g];
        const float A1 = Ao[g], B1 = Bo[g];
        float H0, P0, H1, P1;
        if (E == 0) { H0 = Hc; P0 = Pc; Hc = __builtin_fmaf(A0, Hc, B0); Pc *= A0; H1 = Hc; P1 = Pc; Hc = __builtin_fmaf(A1, Hc, B1); Pc *= A1; }
        else        { H1 = Hc; P1 = Pc; Hc = __builtin_fmaf(A1, Hc, B1); Pc *= A1; H0 = Hc; P0 = Pc; Hc = __builtin_fmaf(A0, Hc, B0); Pc *= A0; }
        cinH[g] = h ? H1 : H0; cinP[g] = h ? P1 : P0;
    }
#pragma unroll
    for (int reg = 0; reg < 16; ++reg) {
        const float lh = __builtin_fmaf(p[reg], cinH[reg >> 2], lcl[reg]), pv = p[reg] * cinP[reg >> 2];
        rrow[((reg & 3) + 8 * (reg >> 2)) * BW] = pk2(lh, pv);
    }
}

__device__ __forceinline__ void lru_local_phase(Frame& F0, KArgs A0, int l) {
    Frame F = F0; { const int t_ = launder_v((int)threadIdx.x); F.tid = t_; F.lane = t_ & 63; F.wave = __builtin_amdgcn_readfirstlane(t_ >> 6); }
    KArgs A = A0; asm volatile("" : "+s"(A));
    LAS float* X32 = (LAS float*)(F.lds + RING_OFF + LRU_X32);
    LAS unsigned char* X16 = F.lds + RING_OFF + LRU_X16;
    LAS unsigned* RES = (LAS unsigned*)(F.lds + RING_OFF + LRU_RES);
    const int tid = F.tid, lane = F.lane;
    const int e = F.wave & 1, cb = F.wave >> 1, jl = lane & 31, h = lane >> 5;
    const int ch4 = tid & 31, tq = tid >> 5;
    bf16x8 WR[8], WI[8]; float bR = 0.f, bI = 0.f, c1 = 0.f; int last_n = -1;
#define LRU_LOAD_ROWS(dst, uu) do { const int n_ = (uu) & (NBLK - 1), pc_ = (uu) >> 4, b_ = pc_ / NCH, t0_ = (pc_ % NCH) * TC; \
        const bf16* xa_ = F_PB + p_idx((size_t)(b_ * SEQ), OFF_XA + n_ * BW) + 4 * ch4; \
        _Pragma("unroll") for (int i_ = 0; i_ < 7; ++i_) { const int t_ = t0_ + 4 * tq - 2 + i_; const int tc_ = min(max(t_, 0), SEQ - 1); \
            (dst)[i_] = *(const v2u*)(xa_ + (size_t)tc_ * 128); } } while (0)
    v2u rwn[7];
    if (F.cid < BATCH * NCH * NBLK) LRU_LOAD_ROWS(rwn, F.cid);
    for (int u = F.cid; u < BATCH * NCH * NBLK; u += F.G) {
        const int n = u & (NBLK - 1), pc = u >> 4, b = pc / NCH, cidx = pc % NCH, t0 = cidx * TC;
        if (n != last_n) {
            last_n = n;
            const bf16* wr = F_WAT + ((size_t)((l * 2 + e) * NBLK + n) * BW + 32 * cb + jl) * BW + 8 * h;
            const bf16* wi = F_WXT + ((size_t)((l * 2 + e) * NBLK + n) * BW + 32 * cb + jl) * BW + 8 * h;
#pragma unroll
            for (int s = 0; s < 8; ++s) { WR[s] = *(const bf16x8*)(wr + 16 * s); WI[s] = *(const bf16x8*)(wi + 16 * s); }
            const int ch = n * BW + 32 * cb + jl;
            bR = F_lru_ba[(size_t)(l * 2 + e) * WL + ch]; bI = F_lru_bx[(size_t)(l * 2 + e) * WL + ch];
            c1 = -C_RG * LOG2E * log1pf(expf(-F_lru_lambda[(size_t)(l * 2 + e) * WL + ch]));
        }
        {
            f32x4 rw[7];
#pragma unroll
            for (int i = 0; i < 7; ++i) { const bool in_ = (unsigned)(t0 + 4 * tq - 2 + i) < (unsigned)SEQ;
                const unsigned wx_ = in_ ? rwn[i].x : 0u, wy_ = in_ ? rwn[i].y : 0u; rw[i] = (f32x4){bflo(wx_), bfhi(wx_), bflo(wy_), bfhi(wy_)}; }
            const float* cwp = F_conv_w + (size_t)l * 4 * WL + n * BW + 4 * ch4;
            const f32x4 w0 = *(const f32x4*)(cwp), w1 = *(const f32x4*)(cwp + WL), w2 = *(const f32x4*)(cwp + 2 * WL), w3 = *(const f32x4*)(cwp + 3 * WL);
            const f32x4 cbv = *(const f32x4*)(F_conv_b + (size_t)l * WL + n * BW + 4 * ch4);
#pragma unroll
            for (int i = 0; i < 4; ++i) { const f32x4 xc = cbv + w0 * rw[i] + w1 * rw[i + 1] + w2 * rw[i + 2] + w3 * rw[i + 3];
                const int t = 4 * tq + i;
                *(LAS f32x4*)(X32 + t * BW + 4 * ch4) = xc;
                v2u w; w.x = pk2(xc.x, xc.y); w.y = pk2(xc.z, xc.w); *(LAS v2u*)(X16 + (t * X16P + 4 * ch4) * 2) = w; }
        }
        if (u + F.G < BATCH * NCH * NBLK) LRU_LOAD_ROWS(rwn, u + F.G);
        __syncthreads();
        {
            float Hc = 0.f, Pc = 1.f;
#pragma unroll
            for (int tt = 0; tt < TC / 32; ++tt) {
                const int tile = e ? (TC / 32 - 1 - tt) : tt;
                bf16x8 Af[8];
                const LAS unsigned char* ap = X16 + ((32 * tile + jl) * X16P + 8 * h) * 2;
#pragma unroll
                for (int s = 0; s < 8; ++s) Af[s] = *(const LAS bf16x8*)(ap + 32 * s);
                f32x16 accR, accI;
#pragma unroll
                for (int i = 0; i < 16; ++i) { accR[i] = 0.f; accI[i] = 0.f; }
#pragma unroll
                for (int s = 0; s < 8; ++s) { accR = __builtin_amdgcn_mfma_f32_32x32x16_bf16(Af[s], WR[s], accR, 0, 0, 0); accI = __builtin_amdgcn_mfma_f32_32x32x16_bf16(Af[s], WI[s], accI, 0, 0, 0); }
                const LAS float* xrow = X32 + (32 * tile + 4 * h) * BW + 32 * cb + jl;
                LAS unsigned* rrow = RES + (e * TC + 32 * tile + 4 * h) * BW + 32 * cb + jl;
                if (e == 0) lru_tile<0>(accR, accI, xrow, rrow, h, bR, bI, c1, Hc, Pc); else lru_tile<1>(accR, accI, xrow, rrow, h, bR, bI, c1, Hc, Pc);
            }
            if (h == 0) { gu64* sp = (gu64*)(F_SUM + ((size_t)((b * NCH + cidx) * 2 + e) * WL + n * BW + 32 * cb + jl) * 2);
                __hip_atomic_store(sp, ((unsigned long long)__builtin_bit_cast(unsigned, Hc) << 32) | __builtin_bit_cast(unsigned, Pc), RLX_AGENT); }
        }
        __syncthreads();
        {
#pragma unroll
            for (int i = 0; i < 4; ++i) { const int t = 4 * tq + i;
                const v4u f = *(const LAS v4u*)(RES + t * BW + 4 * ch4), k = *(const LAS v4u*)(RES + (TC + t) * BW + 4 * ch4);
                v2u lh, pf, pb;
                lh.x = pk2(bflo(f.x) + bflo(k.x), bflo(f.y) + bflo(k.y)); lh.y = pk2(bflo(f.z) + bflo(k.z), bflo(f.w) + bflo(k.w));
                pf.x = (f.x >> 16) | (f.y & 0xffff0000u); pf.y = (f.z >> 16) | (f.w & 0xffff0000u);
                pb.x = (k.x >> 16) | (k.y & 0xffff0000u); pb.y = (k.z >> 16) | (k.w & 0xffff0000u);
                const size_t o = ((size_t)((b * NCH + cidx) * NBLK + n) * TC + t) * BW + 4 * ch4;
                *(v2u*)(F_LH + o) = lh; *(v2u*)(F_PF + o) = pf; *(v2u*)(F_PBK + o) = pb; }
        }
    }
#undef LRU_LOAD_ROWS
    {
        const int n = F.cid & (NBLK - 1);
        LAS unsigned* flg = (LAS unsigned*)(F.lds + RING_OFF + LRU_END);
        asm volatile("s_waitcnt vmcnt(0)" ::: "memory");
        __syncthreads();
        if (tid == 0) { const unsigned old = __hip_atomic_fetch_add((unsigned*)(F_ctl + CW_CARRY + 16 * (16 * l + n)), 1u, __ATOMIC_RELAXED, __HIP_MEMORY_SCOPE_AGENT);
            if (old == (unsigned)(F.G / NBLK) - 1u) { __builtin_amdgcn_fence(__ATOMIC_ACQUIRE, "agent"); asm volatile("s_waitcnt vmcnt(0)" ::: "memory"); }
            flg[0] = (old == (unsigned)(F.G / NBLK) - 1u) ? 1u : 0u; }
        __syncthreads();
        if (flg[0] != 0u) {
            const int bb = tid >> 8, ee = (tid >> 7) & 1, ch = n * BW + (tid & 127);
            float cin = 0.f;
#ifndef CHB
#define CHB 32
#endif
#pragma unroll 1
            for (int s0 = 0; s0 < NCH; s0 += CHB) {
                unsigned long long sw_[CHB];
#pragma unroll
                for (int s = 0; s < CHB; ++s) { const int ci = ee ? (NCH - 1 - (s0 + s)) : (s0 + s);
                    sw_[s] = __hip_atomic_load((gu64*)(F_SUM + ((size_t)((bb * NCH + ci) * 2 + ee) * WL + ch) * 2), RLX_AGENT); }
#pragma unroll
                for (int s = 0; s < CHB; ++s) { const int ci = ee ? (NCH - 1 - (s0 + s)) : (s0 + s);
                    const size_t o = (size_t)((bb * NCH + ci) * 2 + ee) * WL + ch;
                    __hip_atomic_store((gu32*)(F_CAR + o), __builtin_bit_cast(unsigned, cin), RLX_AGENT);
                    cin = __builtin_fmaf(__builtin_bit_cast(float, (unsigned)sw_[s]), cin, __builtin_bit_cast(float, (unsigned)(sw_[s] >> 32))); }
            }
            asm volatile("s_waitcnt vmcnt(0)" ::: "memory");
            __syncthreads();
            if (tid == 0) __hip_atomic_store((gu32*)(F_ctl + CW_CREADY + 16 * (16 * l + n)), 1u, RLX_AGENT);
        }
        __syncthreads();
    }
}

typedef short s16x4 __attribute__((ext_vector_type(4)));
typedef LAS s16x4 lds_s16x4;
constexpr int ATT_SLOT = 32768;
constexpr int ATT_NSLOT = 4;
constexpr int ATT_BTAB = ATT_NSLOT * ATT_SLOT;
static_assert(ATT_BTAB + 2048 <= PHASE_LDS, "attention LDS map");

template <int DLT>
__device__ __forceinline__ void attn_pair_task(KArgs A, int l, int b, int h, int j4, int wave, int lane, LAS unsigned char* ring, const LAS float* btab) {
    constexpr int NU = 8 + DLT;
    const int q = lane & 15, g = lane >> 4, pr = wave >> 2, qt = wave & 3;
    const float SCL2 = 0.08838834764831845f * LOG2E;
    const int rA = 4 * j4 + 2 * pr, rB = rA + 1;
    const int kr0 = min(max(4 * j4 - 4, 0), ROWS - KR);
    const int rs = min(max(rA - 4, 0), ROWS - KR);
    const int PRE = rs - kr0, NS = min(max(4 * j4 - 2, 0), ROWS - KR) + NU - kr0;
    const int c0 = 16 * qt, kb = min(max(c0 - 8, 0), 32), xb = (kb >> 3) & 1;
    const int c = c0 + q, cs = min(max(c - 8, 0), GW - KC);
    const char* ksrc = (const char*)(F_PB + p_idx((size_t)(b * SEQ + kr0 * GW), OFF_K + h * HD)) + 2048 * wave;
    const char* vsrc = (const char*)(F_PB + p_idx((size_t)(b * SEQ + kr0 * GW), OFF_V + h * HD)) + 2048 * wave;
    LAS unsigned char* dstw = ring + 2048 * wave;
    const unsigned lofs0 = (unsigned)(g * 128) * 2u + 16u * (unsigned)(q ^ ((g << 2) | ((2 * wave) & 3)));
    const unsigned lofs1 = (unsigned)(g * 128) * 2u + 16u * (unsigned)(q ^ ((g << 2) | ((2 * wave + 1) & 3)));
#define ROW_DMA(s_) do { const int s2_ = (s_), r2_ = min(s2_, NS - 1);     \
        const char* kp_ = ksrc + (size_t)r2_ * (GW * 256); const char* vp_ = vsrc + (size_t)r2_ * (GW * 256); LAS unsigned char* d_ = dstw + (s2_ & (ATT_NSLOT - 1)) * ATT_SLOT; \
        asm volatile("" : "+s"(kp_), "+s"(vp_));                     \
        __builtin_amdgcn_global_load_lds((const unsigned*)(kp_ + lofs0), (LAS unsigned*)(d_), 16, 0, 0); \
        __builtin_amdgcn_global_load_lds((const unsigned*)(kp_ + 1024 + lofs1), (LAS unsigned*)(d_ + 1024), 16, 0, 0); \
        __builtin_amdgcn_global_load_lds((const unsigned*)(vp_ + lofs0), (LAS unsigned*)(d_ + 16384), 16, 0, 0); \
        __builtin_amdgcn_global_load_lds((const unsigned*)(vp_ + 1024 + lofs1), (LAS unsigned*)(d_ + 16384 + 1024), 16, 0, 0); } while (0)
#define ROW_SYNC(s_) do { const int s1_ = (s_); asm volatile("s_waitcnt vmcnt(8)" ::: "memory"); __builtin_amdgcn_s_barrier(); asm volatile("" ::: "memory"); ROW_DMA(s1_ + 3); } while (0)
    bf16x8 QA[4], QB[4];
    { const bf16* qp = F_PB + p_idx((size_t)(b * SEQ + rA * GW + c), OFF_Q + h * HD) + 8 * g;
#pragma unroll
      for (int s = 0; s < 4; ++s) { QA[s] = *(const bf16x8*)(qp + 32 * s); QB[s] = *(const bf16x8*)(qp + (size_t)GW * 128 + 32 * s); } }
    asm volatile("s_waitcnt vmcnt(0)" : "+v"(QA[0]), "+v"(QA[1]), "+v"(QA[2]), "+v"(QA[3]), "+v"(QB[0]), "+v"(QB[1]), "+v"(QB[2]), "+v"(QB[3]) :: "memory");
    ROW_DMA(0); ROW_DMA(1); ROW_DMA(2);
    const unsigned ringa = (unsigned)(size_t)ring;
    const unsigned kf0 = ringa + 256u * (unsigned)(kb + 8 * (q >> 2) + (q & 3)) + 16u * (unsigned)(g ^ (2 * xb) ^ ((2 * (q >> 2)) & 3));
    const unsigned kf1 = ringa + 256u * (unsigned)(kb + 8 * (q >> 2) + 4 + (q & 3)) + 16u * (unsigned)(g ^ (2 * xb) ^ ((2 * (q >> 2) + 1) & 3));
    const unsigned kx = 64u * (unsigned)(q & 3);
    const unsigned tqq = (unsigned)(q >> 2), tp = (unsigned)(q & 3);
    const unsigned tr0 = ringa + 16384u + 256u * (unsigned)(kb + 8 * g) + 256u * tqq + 32u * ((tqq << 1) | (unsigned)((g & 1) ^ xb)) + 16u * (tp >> 1) + 8u * (tp & 1);
    const unsigned tr1 = ringa + 16384u + 256u * (unsigned)(kb + 8 * g + 4) + 256u * tqq + 32u * ((tqq << 1) | (unsigned)((g & 1) ^ xb)) + 16u * ((tp >> 1) ^ 1u) + 8u * (tp & 1);
    const int dv = kb + 8 * g - cs;
    const LAS float* btA = btab + 8 + (rs - rA + (KR - 1)) * (2 * KC - 1) + (kb + 8 * g - c + (KC - 1));
    const LAS float* btB = btA - (2 * KC - 1);
    float mA = -INFINITY, mB = -INFINITY, lA = 0.f, lB = 0.f;
    f32x4 oA[8], oB[8];
#pragma unroll
    for (int c4 = 0; c4 < 8; ++c4) { oA[c4] = (f32x4){0.f, 0.f, 0.f, 0.f}; oB[c4] = (f32x4){0.f, 0.f, 0.f, 0.f}; }
    for (int s = 0; s < PRE; ++s) ROW_SYNC(s);
#pragma unroll
    for (int u = 0; u < NU; ++u) {
        ROW_SYNC(PRE + u);
        unsigned sb = (unsigned)((PRE + u) & (ATT_NSLOT - 1)) * (unsigned)ATT_SLOT;
        asm volatile("" : "+s"(sb));
        float bsA[8], bsB[8];
#pragma unroll
        for (int j = 0; j < 8; ++j) { bsA[j] = (u < 8) ? btA[(2 * KC - 1) * u + j] : 0.f; bsB[j] = (u >= DLT) ? btB[(2 * KC - 1) * u + j] : 0.f; }
        f32x4 a0 = {0.f, 0.f, 0.f, 0.f}, a1 = {0.f, 0.f, 0.f, 0.f}, b0 = {0.f, 0.f, 0.f, 0.f}, b1 = {0.f, 0.f, 0.f, 0.f};
#pragma unroll
        for (int s = 0; s < 4; ++s) {
            const bf16x8 k0 = *(const LAS bf16x8*)(size_t)(kf0 + sb + ((64u * s) ^ kx)), k1 = *(const LAS bf16x8*)(size_t)(kf1 + sb + ((64u * s) ^ kx));
            if (u < 8) { a0 = __builtin_amdgcn_mfma_f32_16x16x32_bf16(k0, QA[s], a0, 0, 0, 0); a1 = __builtin_amdgcn_mfma_f32_16x16x32_bf16(k1, QA[s], a1, 0, 0, 0); }
            if (u >= DLT) { b0 = __builtin_amdgcn_mfma_f32_16x16x32_bf16(k0, QB[s], b0, 0, 0, 0); b1 = __builtin_amdgcn_mfma_f32_16x16x32_bf16(k1, QB[s], b1, 0, 0, 0); } }
        asm volatile("s_waitcnt lgkmcnt(0)" : "+v"(bsA[0]), "+v"(bsA[1]), "+v"(bsA[2]), "+v"(bsA[3]), "+v"(bsA[4]), "+v"(bsA[5]), "+v"(bsA[6]), "+v"(bsA[7]),
                                             "+v"(bsB[0]), "+v"(bsB[1]), "+v"(bsB[2]), "+v"(bsB[3]), "+v"(bsB[4]), "+v"(bsB[5]), "+v"(bsB[6]), "+v"(bsB[7]) :: "memory");
        bf16x8 PA, PB_;
        if (u < 8) {
            float v[8], rm = -INFINITY;
#pragma unroll
            for (int j = 0; j < 8; ++j) { const float t_ = __builtin_fmaf(j < 4 ? a0[j & 3] : a1[j & 3], SCL2, bsA[j]); v[j] = ((unsigned)(dv + j) < (unsigned)KC) ? t_ : -INFINITY; rm = fmaxf(rm, v[j]); }
            rm = xor32_max(xor16_max(rm));
            const float mn = fmaxf(mA, rm), al = __builtin_amdgcn_exp2f(mA - mn); mA = mn;
            float ps = 0.f;
#pragma unroll
            for (int j = 0; j < 8; ++j) { v[j] = __builtin_amdgcn_exp2f(v[j] - mn); ps += v[j]; }
            lA = __builtin_fmaf(lA, al, ps); asm volatile("" : "+v"(lA));
#pragma unroll
            for (int c4 = 0; c4 < 8; ++c4) oA[c4] *= al;
            v4u w; w.x = pk2(v[0], v[1]); w.y = pk2(v[2], v[3]); w.z = pk2(v[4], v[5]); w.w = pk2(v[6], v[7]); PA = __builtin_bit_cast(bf16x8, w);
        }
        if (u >= DLT) {
            float v[8], rm = -INFINITY;
#pragma unroll
            for (int j = 0; j < 8; ++j) { const float t_ = __builtin_fmaf(j < 4 ? b0[j & 3] : b1[j & 3], SCL2, bsB[j]); v[j] = ((unsigned)(dv + j) < (unsigned)KC) ? t_ : -INFINITY; rm = fmaxf(rm, v[j]); }
            rm = xor32_max(xor16_max(rm));
            const float mn = fmaxf(mB, rm), al = __builtin_amdgcn_exp2f(mB - mn); mB = mn;
            float ps = 0.f;
#pragma unroll
            for (int j = 0; j < 8; ++j) { v[j] = __builtin_amdgcn_exp2f(v[j] - mn); ps += v[j]; }
            lB = __builtin_fmaf(lB, al, ps); asm volatile("" : "+v"(lB));
#pragma unroll
            for (int c4 = 0; c4 < 8; ++c4) oB[c4] *= al;
            v4u w; w.x = pk2(v[0], v[1]); w.y = pk2(v[2], v[3]); w.z = pk2(v[4], v[5]); w.w = pk2(v[6], v[7]); PB_ = __builtin_bit_cast(bf16x8, w);
        }
        asm volatile("s_waitcnt lgkmcnt(0)" ::: "memory");
        {
            const unsigned t0 = tr0 + sb, t1 = tr1 + sb;
            s16x4 lo[8], hi[8];
#define TR8(dst, base) asm volatile("ds_read_b64_tr_b16 %0, %8\n\tds_read_b64_tr_b16 %1, %9\n\tds_read_b64_tr_b16 %2, %10\n\tds_read_b64_tr_b16 %3, %11\n\t" \
                "ds_read_b64_tr_b16 %4, %12\n\tds_read_b64_tr_b16 %5, %13\n\tds_read_b64_tr_b16 %6, %14\n\tds_read_b64_tr_b16 %7, %15\n\ts_waitcnt lgkmcnt(0)" \
                : "=&v"((dst)[0]), "=&v"((dst)[1]), "=&v"((dst)[2]), "=&v"((dst)[3]), "=&v"((dst)[4]), "=&v"((dst)[5]), "=&v"((dst)[6]), "=&v"((dst)[7]) \
                : "v"((base) ^ 0u), "v"((base) ^ 32u), "v"((base) ^ 64u), "v"((base) ^ 96u), "v"((base) ^ 128u), "v"((base) ^ 160u), "v"((base) ^ 192u), "v"((base) ^ 224u) : "memory")
            TR8(lo, t0); TR8(hi, t1);
#undef TR8
#pragma unroll
            for (int c4 = 0; c4 < 8; ++c4) { const bf16x8 vf = __builtin_shufflevector(lo[c4], hi[c4], 0, 1, 2, 3, 4, 5, 6, 7);
                if (u < 8) oA[c4] = __builtin_amdgcn_mfma_f32_16x16x32_bf16(vf, PA, oA[c4], 0, 0, 0);
                if (u >= DLT) oB[c4] = __builtin_amdgcn_mfma_f32_16x16x32_bf16(vf, PB_, oB[c4], 0, 0, 0); }
        }
        asm volatile("s_waitcnt lgkmcnt(0)" ::: "memory");
    }
    for (int s = PRE + NU; s < NS; ++s) ROW_SYNC(s);
#undef ROW_DMA
#undef ROW_SYNC
    lA = xor32_sum(xor16_sum(lA)); lB = xor32_sum(xor16_sum(lB));
    const float invA = 1.0f / lA, invB = 1.0f / lB;
    int ce = c; asm volatile("" : "+v"(ce));
    const int gl = launder_v(lane) >> 4, dB = 8 * (gl >> 1) + 16 * (gl & 1);
    f32x4 gn[4][2];
    { const float* gnp = F_gn_att + (size_t)l * WA + h * HD + dB;
#pragma unroll
      for (int m = 0; m < 4; ++m) { gn[m][0] = *(const f32x4*)(gnp + 32 * m); gn[m][1] = *(const f32x4*)(gnp + 32 * m + 4); } }
#pragma unroll
    for (int w2 = 0; w2 < 2; ++w2) {
        f32x4 (&o)[8] = w2 ? oB : oA; const float inv = w2 ? invB : invA;
        const size_t tok = (size_t)(b * SEQ + (w2 ? rB : rA) * GW + ce);
        const bf16* gbp = F_PB + p_idx(tok, OFF_GB + h * HD) + dB;
        v4u gw_[4];
#pragma unroll
        for (int m = 0; m < 4; ++m) gw_[m] = *(const v4u*)(gbp + 32 * m);
        float ss = 0.f;
#pragma unroll
        for (int c4 = 0; c4 < 8; ++c4) { o[c4] *= inv; ss += (o[c4].x * o[c4].x + o[c4].y * o[c4].y) + (o[c4].z * o[c4].z + o[c4].w * o[c4].w); }
#pragma unroll
        for (int m = 0; m < 4; ++m)
#pragma unroll
            for (int r = 0; r < 4; ++r) { const float e0_ = o[2 * m][r], e1_ = o[2 * m + 1][r];
                const auto sw_ = __builtin_amdgcn_permlane16_swap(__builtin_bit_cast(unsigned, e0_), __builtin_bit_cast(unsigned, e1_), false, false);
                const unsigned s0_ = sw_[0], s1_ = sw_[1]; o[2 * m][r] = __builtin_bit_cast(float, s0_); o[2 * m + 1][r] = __builtin_bit_cast(float, s1_); }
#pragma unroll
        for (int m = 0; m < 4; ++m) { const f32x4 v0 = o[2 * m] * gn[m][0], v1 = o[2 * m + 1] * gn[m][1];
            v4u w; w.x = pk2(v0.x * siluf_(bflo(gw_[m].x)), v0.y * siluf_(bfhi(gw_[m].x))); w.y = pk2(v0.z * siluf_(bflo(gw_[m].y)), v0.w * siluf_(bfhi(gw_[m].y)));
            w.z = pk2(v1.x * siluf_(bflo(gw_[m].z)), v1.y * siluf_(bfhi(gw_[m].z))); w.w = pk2(v1.z * siluf_(bflo(gw_[m].w)), v1.w * siluf_(bfhi(gw_[m].w)));
            *(v4u*)(F_YC + a_tiled(tok, h * HD + 32 * m + dB)) = w; }
        ss = xor32_sum(xor16_sum(ss));
        if (gl == 0) F_SSQ[tok * NH + h] = ss;
    }
}

__device__ __forceinline__ void attn_phase(Frame& F0, KArgs A0, int l) {
    Frame F = F0; { const int t_ = launder_v((int)threadIdx.x); F.tid = t_; F.lane = t_ & 63; F.wave = __builtin_amdgcn_readfirstlane(t_ >> 6); }
    KArgs A = A0; asm volatile("" : "+s"(A));
    const int lane = F.lane;
    LAS unsigned char* ring = F.lds + RING_OFF;
    LAS float* btab = (LAS float*)(F.lds + RING_OFF + ATT_BTAB);
    const int xg = F.cid & 7, j4 = (F.cid >> 3) & 15;
    for (int it = 0; it < (BATCH * NH) / 16; ++it) {
        const int pair = xg + 8 * (2 * it + (F.cid >> 7)), b = pair >> 4, h = pair & 15;
        asm volatile("s_waitcnt vmcnt(0) lgkmcnt(0)" ::: "memory");
        __syncthreads();
        {
            const float* rpb_ = F_rpb + (size_t)(l * NH + h) * ((2 * KR - 1) * (2 * KC - 1));
            if (F.tid < 512) { const int idx = F.tid - 8; btab[F.tid] = (idx >= 0 && idx < (2 * KR - 1) * (2 * KC - 1)) ? rpb_[idx] * LOG2E : 0.f; }
        }
        __syncthreads();
        const int r0 = 4 * j4;
        const int dlt = min(max(r0 - 3, 0), ROWS - KR) - min(max(r0 - 4, 0), ROWS - KR);
        if (dlt == 0) attn_pair_task<0>(A, l, b, h, j4, F.wave, lane, ring, btab);
        else          attn_pair_task<1>(A, l, b, h, j4, F.wave, lane, ring, btab);
    }
    asm volatile("s_waitcnt vmcnt(0) lgkmcnt(0)" ::: "memory");
}

__device__ __forceinline__ void lru_fix_phase(Frame& F0, KArgs A0, int l) {
    Frame F = F0; { const int t_ = launder_v((int)threadIdx.x); F.tid = t_; F.lane = t_ & 63; F.wave = __builtin_amdgcn_readfirstlane(t_ >> 6); }
    KArgs A = A0; asm volatile("" : "+s"(A));
    const int tid = F.tid, n = F.cid & (NBLK - 1), ch4 = tid & 31, tq = tid >> 5;
    if (tid == 0) {
        gu32* flag = (gu32*)(F_ctl + CW_CREADY + 16 * (16 * l + n)); unsigned sp = 0;
        while (__hip_atomic_load(flag, RLX_AGENT) == 0u) { __builtin_amdgcn_s_sleep(2);
            if ((++sp & 1023u) == 0u && sp > (1u << 22)) { __hip_atomic_store((gu32*)(F_ctl + CW_TMO), 1u, RLX_AGENT); break; } }
        __builtin_amdgcn_fence(__ATOMIC_ACQUIRE, "agent");
        asm volatile("s_waitcnt vmcnt(0)" ::: "memory");
    }
    __syncthreads();
    const float* gl = F_gn_lru + (size_t)l * WL + n * BW + 4 * ch4;
    const f32x4 g4 = *(const f32x4*)gl;
    for (int u = F.cid; u < BATCH * NCH * NBLK; u += F.G) {
        const int pc = u >> 4, b = pc / NCH, cidx = pc % NCH, t0 = cidx * TC;
        const size_t co = (size_t)((b * NCH + cidx) * 2) * WL + n * BW + 4 * ch4;
        const unsigned long long c0 = __hip_atomic_load((gu64*)(F_CAR + co), RLX_AGENT), c1 = __hip_atomic_load((gu64*)(F_CAR + co + 2), RLX_AGENT);
        const unsigned long long d0 = __hip_atomic_load((gu64*)(F_CAR + co + WL), RLX_AGENT), d1 = __hip_atomic_load((gu64*)(F_CAR + co + WL + 2), RLX_AGENT);
        const f32x4 cf = {__builtin_bit_cast(float, (unsigned)c0), __builtin_bit_cast(float, (unsigned)(c0 >> 32)), __builtin_bit_cast(float, (unsigned)c1), __builtin_bit_cast(float, (unsigned)(c1 >> 32))};
        const f32x4 cb = {__builtin_bit_cast(float, (unsigned)d0), __builtin_bit_cast(float, (unsigned)(d0 >> 32)), __builtin_bit_cast(float, (unsigned)d1), __builtin_bit_cast(float, (unsigned)(d1 >> 32))};
        v2u lhw[4], pfw[4], pbw[4], gg[4];
#pragma unroll
        for (int i = 0; i < 4; ++i) { const size_t tok = (size_t)(b * SEQ + t0 + 4 * tq + i), o = ((size_t)((b * NCH + cidx) * NBLK + n) * TC + 4 * tq + i) * BW + 4 * ch4;
            lhw[i] = *(const v2u*)(F_LH + o); pfw[i] = *(const v2u*)(F_PF + o); pbw[i] = *(const v2u*)(F_PBK + o); gg[i] = *(const v2u*)(F_PB + p_idx(tok, OFF_GA + n * BW) + 4 * ch4); }
        float q[4];
#pragma unroll
        for (int i = 0; i < 4; ++i) { const size_t tok = (size_t)(b * SEQ + t0 + 4 * tq + i);
            const f32x4 lh = {bflo(lhw[i].x), bfhi(lhw[i].x), bflo(lhw[i].y), bfhi(lhw[i].y)}, pf = {bflo(pfw[i].x), bfhi(pfw[i].x), bflo(pfw[i].y), bfhi(pfw[i].y)}, pb = {bflo(pbw[i].x), bfhi(pbw[i].x), bflo(pbw[i].y), bfhi(pbw[i].y)};
            const f32x4 ya = lh + pf * cf + pb * cb;
            q[i] = (ya.x * ya.x + ya.y * ya.y) + (ya.z * ya.z + ya.w * ya.w);
            v2u w; w.x = pk2(ya.x * g4.x * siluf_(bflo(gg[i].x)), ya.y * g4.y * siluf_(bfhi(gg[i].x))); w.y = pk2(ya.z * g4.z * siluf_(bflo(gg[i].y)), ya.w * g4.w * siluf_(bfhi(gg[i].y)));
            *(v2u*)(F_YC + a_tiled(tok, WL + n * BW + 4 * ch4)) = w; }
#pragma unroll
        for (int i = 0; i < 4; ++i) {
#pragma unroll
            for (int o = 1; o < 32; o <<= 1) q[i] += __shfl_xor(q[i], o);
            if (ch4 == 0) F_SSA[(size_t)(b * SEQ + t0 + 4 * tq + i) * NBLK + n] = q[i]; }
    }
}

#ifndef REP_P0
#define REP_P0 1
#endif
#ifndef REP_P0A
#define REP_P0A 1
#endif
#ifndef REP_NORM
#define REP_NORM 1
#endif
#ifndef REP_G1
#define REP_G1 1
#endif
#ifndef REP_LRU
#define REP_LRU 1
#endif
#ifndef REP_ATT
#define REP_ATT 1
#endif
#ifndef REP_FIX
#define REP_FIX 1
#endif
#ifndef G1_ALIGN
#define G1_ALIGN true
#endif
#ifndef G1_SP2
#define G1_SP2 true
#endif
#ifndef G2_ALIGN
#define G2_ALIGN true
#endif
#ifndef G2_SP2
#define G2_SP2 true
#endif
constexpr int NPL = 6;
constexpr int NPHASE = 2 + NPL * DEPTH + 1;
__global__ void __launch_bounds__(NWAVES * 64, 2) trunk_fwd(Args args) {
    extern __shared__ __attribute__((aligned(16))) unsigned char lds[];
    Frame F;
    F.lds = (LAS unsigned char*)lds;
    F.MISC = (volatile LAS unsigned*)(F.lds + MISC_OFF);
    F.tid = threadIdx.x; F.lane = F.tid & 63; F.wave = __builtin_amdgcn_readfirstlane(F.tid >> 6);
    F.G = gridDim.x; { const int bx = blockIdx.x; F.vcu = (F.G % 8 == 0) ? (bx % 8) * (F.G / 8) + bx / 8 : bx; }
    KArgs A_ = (KArgs)__builtin_amdgcn_kernarg_segment_ptr(); KArgs A = A_;
    for (int u = F.tid; u < (LDS_BYTES - LDSCTL_OFF) / 4; u += NWAVES * 64) ((LAS unsigned*)(F.lds + LDSCTL_OFF))[u] = 0u;
    __syncthreads();
    XcdBarrier bar = xcd_barrier_post((unsigned*)(F_ctl + CW_BAR) + args.li * XCD_BAR_WORDS, F.MISC + 8);
    F.cid = (int)blockIdx.x;
    if (F.tid == 0) F.MISC[10] = __hip_atomic_fetch_add((unsigned*)(F_ctl + CW_RANK + 64 * (int)bar.x), 1u, __ATOMIC_RELAXED, __HIP_MEMORY_SCOPE_AGENT);
#ifndef REP_BAR
#define REP_BAR 1
#endif
#define GRID_BAR() do { for (int rb_ = 0; rb_ < REP_BAR; ++rb_) xcd_barrier(bar); } while (0)
    const int lo = args.ph_lo, hi = args.ph_hi;
#define IN(k) (lo <= (k) && (k) < hi)
#define BOTH(k) (IN(k) && IN((k) + 1))

    if (IN(0)) { for (int rep = 0; rep < REP_P0A; ++rep) p0_mod_phase(F, A); if (BOTH(0)) GRID_BAR(); }
    if (BOTH(0)) {
        if (F.tid == 0) { bool uni = (F.G == 256);
            for (int j = 0; j < 16; ++j) { const unsigned cnt = xb_ld(&bar.bar[XB_XCNT(j)]); uni = uni && (cnt == (j < 8 ? 32u : 0u)); }
            F.MISC[11] = uni ? (F.MISC[10] * 8u + bar.x) : (unsigned)blockIdx.x; }
        __syncthreads();
        F.cid = (int)F.MISC[11];
        F.vcu = (F.G % 8 == 0) ? (F.cid % 8) * (F.G / 8) + F.cid / 8 : F.cid;
    }

    if (IN(1)) { for (int rep = 0; rep < REP_P0; ++rep) p0_convert_phase(F, A);
        for (int rep = 0; rep < REP_NORM; ++rep) norm0_phase(F, A, F_x, 0);
        if (BOTH(1)) GRID_BAR(); }

    for (int l = 0; l < DEPTH; ++l) {
        const int pb = 2 + NPL * l;
        const float* xin = (l == 0) ? F_x : F_out;
        if (IN(pb + 1)) {
            KArgs A = A_; asm volatile("" : "+s"(A));
            pg8::Gemm g{F_HB, F_WIN + (size_t)l * DIN * D, M, DIN, D}; pg8::StaticOrder S; S.init(M, DIN, F.G, F.cid);
            pg8::Unit u0; S.next(0, u0);
            { LAS float* rt = (LAS float*)(F.lds + RTAB_OFF); const int t2 = launder_v((int)threadIdx.x);
              if (t2 < 256) { const f32x4* rp = (const f32x4*)(F_RS + (size_t)(u0.pm * 256 + t2) * 64); float s = 0.f;
#pragma unroll
                  for (int i = 0; i < 16; ++i) { const f32x4 v = rp[i]; s += (v.x + v.y) + (v.z + v.w); }
                  rt[t2] = 1.0f / sqrtf(s * (1.f / D) + EPS); }
              __syncthreads(); }
            pg8::EpiBf16N E{F_PB, M, F_SW + (size_t)(l * 2) * DIN, DIN, (const LAS float*)(F.lds + RTAB_OFF)};
            for (int rep = 0; rep < REP_G1; ++rep) pg8::gemm_phase<pg8::EpiBf16N, pg8::StaticOrder, G1_ALIGN, G1_SP2>(F.lds + RING_OFF, g, S, E);
            if (BOTH(pb + 1)) GRID_BAR();
        }
        if (IN(pb + 2)) { for (int rep = 0; rep < REP_LRU; ++rep) lru_local_phase(F, A, l); for (int rep = 0; rep < REP_ATT; ++rep) attn_phase(F, A, l); for (int rep = 0; rep < REP_FIX; ++rep) lru_fix_phase(F, A, l); if (BOTH(pb + 2)) GRID_BAR(); }
        if (IN(pb + 5)) {
            KArgs A = A_; asm volatile("" : "+s"(A));
            pg8::Gemm g{F_YC, F_WOUT + (size_t)l * D * D, M, D, D}; pg8::StaticOrder S; S.init(M, D, F.G, F.cid);
            pg8::Unit u0; S.next(0, u0);
            { LAS float* rt = (LAS float*)(F.lds + RTAB_OFF); const int t2 = launder_v((int)threadIdx.x);
              if (t2 < 256) { const f32x4* pa = (const f32x4*)(F_SSA + (size_t)(u0.pm * 256 + t2) * NBLK); const f32x4* pb_ = (const f32x4*)(F_SSQ + (size_t)(u0.pm * 256 + t2) * NH); float sa = 0.f, sb = 0.f;
#pragma unroll
                  for (int i = 0; i < 4; ++i) { const f32x4 va = pa[i], vb = pb_[i]; sa += (va.x + va.y) + (va.z + va.w); sb += (vb.x + vb.y) + (vb.z + vb.w); }
                  const float ra = 1.0f / sqrtf(sa * (1.f / WL) + EPS), rb = 1.0f / sqrtf(sb * (1.f / WA) + EPS);
                  rt[t2] = rb / ra; rt[256 + t2] = ra; }
              __syncthreads(); }
            const bool more = (l + 1 < DEPTH);
            pg8::EpiResid E{F_x, F_out, D, F_MOD + (size_t)(l * 2) * (3 * D) + 2 * D, 3 * D, (const LAS float*)(F.lds + RTAB_OFF),
                            (l > 0) ? F_XB : (const bf16*)nullptr, more ? F_XB : (bf16*)nullptr,
                            more ? F_HB : (bf16*)nullptr, F_norm_g + (size_t)(more ? l + 1 : l) * D, F_MOD + (size_t)((more ? l + 1 : l) * 2) * (3 * D) + D, 3 * D, F_RS};
#ifndef REP_G2L0
#define REP_G2L0 1
#endif
            for (int rep = 0; rep < ((l == 0) ? REP_G2L0 : 1); ++rep) pg8::gemm_phase<pg8::EpiResid, pg8::StaticOrder, G2_ALIGN, G2_SP2>(F.lds + RING_OFF, g, S, E);
            if (BOTH(pb + 5)) GRID_BAR();
        }
    }
    if (IN(NPHASE - 1)) final_norm_phase(F, A, F_out);
#undef IN
#undef BOTH
}

#ifndef MK_SPLIT
#define MK_SPLIT 0
#endif
extern "C" void kernel_launch(void* const* d_in, const int* in_sizes, int n_in, void* d_out, int out_size, void* d_ws, size_t ws_size, hipStream_t stream) {
    static int grid = 0;
    if (grid == 0) {
        if (n_in != 18 || in_sizes[0] != M * D || out_size != M * D || ws_size < WS_END) { fprintf(stderr, "kernel_launch: unexpected shapes (n_in %d, in0 %d, out %d, ws %zu); nothing launched\n", n_in, n_in > 0 ? in_sizes[0] : -1, out_size, ws_size); grid = -1; return; }
        int dev = 0, cus = 0, per_cu = 0;
        if (hipGetDevice(&dev) != hipSuccess || hipDeviceGetAttribute(&cus, hipDeviceAttributeMultiprocessorCount, dev) != hipSuccess) { fprintf(stderr, "kernel_launch: device query failed\n"); grid = -1; return; }
        if (hipFuncSetAttribute((const void*)trunk_fwd, hipFuncAttributeMaxDynamicSharedMemorySize, LDS_BYTES) != hipSuccess) { fprintf(stderr, "kernel_launch: hipFuncSetAttribute failed\n"); grid = -1; return; }
        if (hipOccupancyMaxActiveBlocksPerMultiprocessor(&per_cu, (const void*)trunk_fwd, NWAVES * 64, LDS_BYTES) != hipSuccess || per_cu < 1)
            fprintf(stderr, "kernel_launch: note: occupancy query reports %d workgroups per CU\n", per_cu);
        (void)hipGetLastError();
        grid = cus;
        if (cus != 256) { fprintf(stderr, "kernel_launch: built for a 256-CU device (unit orders, prologue partition); found %d CUs; nothing launched\n", cus); grid = -1; return; }
    }
    if (grid < 0) return;
    if (hipMemsetAsync((char*)d_ws + WS_CTL, 0, CTL_ZERO_BYTES, stream) != hipSuccess) { fprintf(stderr, "kernel_launch: memset failed\n"); return; }
    Args a{};
    for (int i = 0; i < 18; ++i) a.in[i] = (const float*)d_in[i];
    a.out = (float*)d_out; a.ws = (unsigned char*)d_ws; a.pad = 0;
#if MK_SPLIT
    for (int p = 0; p < NPHASE; ++p) { a.ph_lo = p; a.ph_hi = p + 1; a.li = p;
        hipLaunchKernelGGL(trunk_fwd, dim3(grid), dim3(NWAVES * 64), LDS_BYTES, stream, a);
        const hipError_t le = hipPeekAtLastError();
        if (le != hipSuccess) { fprintf(stderr, "kernel_launch: launch %d failed: %s\n", p, hipGetErrorName(le)); break; } }
#else
    a.ph_lo = 0; a.ph_hi = NPHASE; a.li = 0;
    hipLaunchKernelGGL(trunk_fwd, dim3(grid), dim3(NWAVES * 64), LDS_BYTES, stream, a);
    { const hipError_t le = hipPeekAtLastError(); if (le != hipSuccess) fprintf(stderr, "kernel_launch: launch failed: %s\n", hipGetErrorName(le)); }
#endif
}
```
